# Optimizing an MI355X kernel written in HIP

```python
import math
import jax, jax.numpy as jnp
from jax import lax
import numpy as np

D_MODEL = 1024
BATCH = 4
SEQ = 8192
DEPTH = 4

PLE_DIM = 256
BRANCH_WIDTH = 512
N_BRANCH = 3
SSM_WIDTH = BRANCH_WIDTH
SSM_GROUP = 16
SSM_GROUPS = SSM_WIDTH // SSM_GROUP
SSM_STATE = 64
DT_MIN = 1e-3
DT_MAX = 1e-1
CONV_WIDTH = BRANCH_WIDTH
CONV_TAPS = 3
HEAD_DIM = 64
N_Q_HEADS = BRANCH_WIDTH // HEAD_DIM
N_KV_HEADS = 2
GQA_GROUP = N_Q_HEADS // N_KV_HEADS
ATTN_WIDTH = N_Q_HEADS * HEAD_DIM
KV_WIDTH = N_KV_HEADS * HEAD_DIM
WINDOW = 128
BLOCK = WINDOW
ATTN_SCALE = 1.0 / math.sqrt(HEAD_DIM)
REL_BUCKETS = 32
REL_MAX_DIST = 128
FFN_HIDDEN = -(-8 * D_MODEL // (3 * 256)) * 256
RMS_EPS = 1e-6

IN_SIZES = (SSM_WIDTH, CONV_WIDTH, CONV_WIDTH, CONV_WIDTH, ATTN_WIDTH, KV_WIDTH, KV_WIDTH, N_BRANCH * D_MODEL)
IN_WIDTH = SSM_WIDTH + 3 * CONV_WIDTH + ATTN_WIDTH + 2 * KV_WIDTH + N_BRANCH * D_MODEL

kernel_name = "hybrid_s5_shortconv_swa_gated_trunk"


def rms_norm(x, g):
    xf = x.astype(jnp.float32)
    y = xf * lax.rsqrt(jnp.mean(xf * xf, axis=-1, keepdims=True) + RMS_EPS)
    return (y * g.astype(jnp.float32)).astype(x.dtype)


def split_columns(z):
    offs, acc = [], 0
    for s in IN_SIZES[:-1]:
        acc += s
        offs.append(acc)
    return jnp.split(z, offs, axis=-1)


def t5_bucket(dist):
    exact = REL_BUCKETS // 2
    df = jnp.maximum(dist, 1).astype(jnp.float32)
    large = exact + (jnp.log(df / exact) / math.log(REL_MAX_DIST / exact) * (REL_BUCKETS - exact)).astype(jnp.int32)
    large = jnp.minimum(large, REL_BUCKETS - 1)
    return jnp.where(dist < exact, dist, large)


def band_bias_and_mask(rel_table, n_blocks):
    qi = jnp.arange(BLOCK)[:, None]
    kj = jnp.arange(2 * BLOCK)[None, :]
    dist = qi + BLOCK - kj
    band = (dist >= 0) & (dist < WINDOW)
    bucket = t5_bucket(jnp.clip(dist, 0, REL_MAX_DIST - 1))
    bias = jnp.transpose(rel_table[bucket], (2, 0, 1)).astype(jnp.float32)
    blk = jnp.arange(n_blocks)[:, None, None]
    valid = band[None] & ((blk > 0) | (kj[None] >= BLOCK))
    return bias, valid


def s5_ssm(u, lam_re, lam_im, b_re, b_im, c_re, c_im, d_skip, log_dt, w_glu):
    bsz, seq, _ = u.shape
    ug = u.reshape(bsz, seq, SSM_GROUPS, SSM_GROUP)
    dt = jnp.exp(log_dt)[:, None]
    mag = jnp.exp(lam_re * dt)
    ang = lam_im * dt
    a_re = mag * jnp.cos(ang)
    a_im = mag * jnp.sin(ang)
    den = lam_re * lam_re + lam_im * lam_im
    nr = a_re - 1.0
    coef_re = (nr * lam_re + a_im * lam_im) / den
    coef_im = (a_im * lam_re - nr * lam_im) / den
    bb_re = coef_re[..., None] * b_re - coef_im[..., None] * b_im
    bb_im = coef_re[..., None] * b_im + coef_im[..., None] * b_re
    bu_re = jnp.einsum('bsgp,gnp->bsgn', ug, bb_re)
    bu_im = jnp.einsum('bsgp,gnp->bsgn', ug, bb_im)
    a_re_t = jnp.broadcast_to(a_re[None, None], (1, seq, SSM_GROUPS, SSM_STATE))
    a_im_t = jnp.broadcast_to(a_im[None, None], (1, seq, SSM_GROUPS, SSM_STATE))

    def combine(left, right):
        a1r, a1i, b1r, b1i = left
        a2r, a2i, b2r, b2i = right
        return (a2r * a1r - a2i * a1i,
                a2r * a1i + a2i * a1r,
                a2r * b1r - a2i * b1i + b2r,
                a2r * b1i + a2i * b1r + b2i)

    _, _, h_re, h_im = lax.associative_scan(combine, (a_re_t, a_im_t, bu_re, bu_im), axis=1)
    y = jnp.einsum('gpn,bsgn->bsgp', c_re, h_re) - jnp.einsum('gpn,bsgn->bsgp', c_im, h_im)
    y = y.reshape(bsz, seq, SSM_WIDTH) + d_skip * u
    y = jax.nn.gelu(y)
    return y * jax.nn.sigmoid(y @ w_glu)


def short_conv(b_gate, c_gate, xc, conv_w):
    v = c_gate * xc
    vp = jnp.pad(v, ((0, 0), (CONV_TAPS - 1, 0), (0, 0)))
    seq = v.shape[1]
    y = conv_w[0] * vp[:, 0:seq] + conv_w[1] * vp[:, 1:seq + 1] + conv_w[2] * vp[:, 2:seq + 2]
    return b_gate * y


def swa_attention(q, k, v, sinks, bias, valid):
    bsz, seq, _ = q.shape
    nb = seq // BLOCK
    qb = q.reshape(bsz, nb, BLOCK, N_KV_HEADS, GQA_GROUP, HEAD_DIM)

    def with_prev(t):
        tb = t.reshape(bsz, nb, BLOCK, N_KV_HEADS, HEAD_DIM)
        prev = jnp.pad(tb, ((0, 0), (1, 0), (0, 0), (0, 0), (0, 0)))[:, :-1]
        return jnp.concatenate([prev, tb], axis=2)

    kb = with_prev(k)
    vb = with_prev(v)
    s = jnp.einsum('bnqhgd,bnkhd->bnhgqk', qb, kb).astype(jnp.float32) * ATTN_SCALE
    s = s + bias.reshape(N_KV_HEADS, GQA_GROUP, BLOCK, 2 * BLOCK)
    s = jnp.where(valid[None, :, None, None], s, -jnp.inf)
    sink = sinks.astype(jnp.float32).reshape(N_KV_HEADS, GQA_GROUP)[None, None, :, :, None, None]
    m = jnp.maximum(jnp.max(s, axis=-1, keepdims=True), sink)
    pexp = jnp.exp(s - m)
    w = pexp / (jnp.sum(pexp, axis=-1, keepdims=True) + jnp.exp(sink - m))
    o = jnp.einsum('bnhgqk,bnkhd->bnqhgd', w.astype(v.dtype), vb)
    return o.reshape(bsz, seq, ATTN_WIDTH)


def setup_inputs(seed: int = 0) -> dict:
    key = jax.random.key(seed)
    ks = jax.random.split(key, 26)
    f32 = jnp.float32

    def nrm(k, shape, scale):
        return jax.random.normal(k, shape, f32) * scale

    n_idx = jnp.arange(SSM_STATE, dtype=f32)
    log_dt = jax.random.uniform(ks[10], (DEPTH, SSM_GROUPS), f32, math.log(DT_MIN), math.log(DT_MAX))
    return {
        "x": nrm(ks[0], (BATCH, SEQ, D_MODEL), 1.0),
        "p": nrm(ks[1], (DEPTH, BATCH, SEQ, PLE_DIM), 1.0),
        "rel_bias": nrm(ks[2], (REL_BUCKETS, N_Q_HEADS), 0.1),
        "norm_mix": 1.0 + nrm(ks[3], (DEPTH, D_MODEL), 0.02),
        "w_in": nrm(ks[4], (DEPTH, D_MODEL, IN_WIDTH), D_MODEL ** -0.5),
        "ssm_lambda_re": -0.5 + nrm(ks[5], (DEPTH, SSM_GROUPS, SSM_STATE), 0.01),
        "ssm_lambda_im": jnp.pi * n_idx + nrm(ks[6], (DEPTH, SSM_GROUPS, SSM_STATE), 0.01),
        "ssm_b_re": nrm(ks[7], (DEPTH, SSM_GROUPS, SSM_STATE, SSM_GROUP), (2 * SSM_GROUP) ** -0.5),
        "ssm_b_im": nrm(ks[8], (DEPTH, SSM_GROUPS, SSM_STATE, SSM_GROUP), (2 * SSM_GROUP) ** -0.5),
        "ssm_c_re": nrm(ks[9], (DEPTH, SSM_GROUPS, SSM_GROUP, SSM_STATE), SSM_STATE ** -0.5),
        "ssm_c_im": nrm(ks[11], (DEPTH, SSM_GROUPS, SSM_GROUP, SSM_STATE), SSM_STATE ** -0.5),
        "ssm_d": nrm(ks[12], (DEPTH, SSM_WIDTH), 1.0),
        "ssm_log_dt": log_dt,
        "ssm_w_glu": nrm(ks[13], (DEPTH, SSM_WIDTH, SSM_WIDTH), SSM_WIDTH ** -0.5),
        "conv_w": nrm(ks[14], (DEPTH, CONV_TAPS, CONV_WIDTH), CONV_TAPS ** -0.5),
        "attn_sinks": nrm(ks[15], (DEPTH, N_Q_HEADS), 0.5),
        "w_branch": nrm(ks[16], (DEPTH, N_BRANCH, BRANCH_WIDTH, D_MODEL), BRANCH_WIDTH ** -0.5),
        "w_out": nrm(ks[17], (DEPTH, D_MODEL, D_MODEL), D_MODEL ** -0.5),
        "norm_ffn": 1.0 + nrm(ks[18], (DEPTH, D_MODEL), 0.02),
        "w_ffn_in": nrm(ks[19], (DEPTH, D_MODEL, 2 * FFN_HIDDEN), D_MODEL ** -0.5),
        "w_ffn_out": nrm(ks[20], (DEPTH, FFN_HIDDEN, D_MODEL), FFN_HIDDEN ** -0.5),
        "norm_ple": 1.0 + nrm(ks[21], (DEPTH, D_MODEL), 0.02),
        "w_ple_gate": nrm(ks[22], (DEPTH, D_MODEL, D_MODEL), D_MODEL ** -0.5),
        "w_ple_proj": nrm(ks[23], (DEPTH, PLE_DIM, D_MODEL), PLE_DIM ** -0.5),
        "norm_final": 1.0 + nrm(ks[24], (D_MODEL,), 0.02),
    }


def reference(x, p, rel_bias, norm_mix, w_in, ssm_lambda_re, ssm_lambda_im, ssm_b_re, ssm_b_im,
              ssm_c_re, ssm_c_im, ssm_d, ssm_log_dt, ssm_w_glu, conv_w, attn_sinks, w_branch, w_out,
              norm_ffn, w_ffn_in, w_ffn_out, norm_ple, w_ple_gate, w_ple_proj, norm_final):
    seq = x.shape[1]
    bias, valid = band_bias_and_mask(rel_bias, seq // BLOCK)
    for i in range(DEPTH):
        h = rms_norm(x, norm_mix[i])
        z = h @ w_in[i]
        u, cb, cc, cx, q, k, v, gates = split_columns(z)
        y_ssm = s5_ssm(u, ssm_lambda_re[i], ssm_lambda_im[i], ssm_b_re[i], ssm_b_im[i],
                       ssm_c_re[i], ssm_c_im[i], ssm_d[i], ssm_log_dt[i], ssm_w_glu[i])
        y_conv = short_conv(cb, cc, cx, conv_w[i])
        y_attn = swa_attention(q, k, v, attn_sinks[i], bias, valid)
        g = jax.nn.sigmoid(gates)
        merged = (g[..., 0:D_MODEL] * (y_ssm @ w_branch[i, 0])
                  + g[..., D_MODEL:2 * D_MODEL] * (y_conv @ w_branch[i, 1])
                  + g[..., 2 * D_MODEL:3 * D_MODEL] * (y_attn @ w_branch[i, 2]))
        x = x + merged @ w_out[i]
        hf = rms_norm(x, norm_ffn[i]) @ w_ffn_in[i]
        x = x + (jax.nn.silu(hf[..., :FFN_HIDDEN]) * hf[..., FFN_HIDDEN:]) @ w_ffn_out[i]
        pg = jax.nn.sigmoid(rms_norm(x, norm_ple[i]) @ w_ple_gate[i])
        x = x + pg * (p[i] @ w_ple_proj[i])
    return rms_norm(x, norm_final)
```

```cpp
#include <hip/hip_runtime.h>
#include <hip/hip_cooperative_groups.h>
#include <cstdio>
namespace cg = cooperative_groups;

#define LAS __attribute__((address_space(3)))
typedef unsigned short bf16_t;
typedef short bf16x8 __attribute__((ext_vector_type(8)));
typedef float f32x4 __attribute__((ext_vector_type(4)));
typedef unsigned u32x4 __attribute__((ext_vector_type(4)));
typedef unsigned u32x2 __attribute__((ext_vector_type(2)));

#ifndef N_LAYERS
#define N_LAYERS 4
#endif

constexpr int T_TOK = 32768, SEQ = 8192, DM = 1024, ZW = 2816, INW = 5888, FFH = 2816;
constexpr int LCH = 32;
constexpr size_t MiB = 1048576;
constexpr size_t OFF_WB = 0, WB_BYTES = 36 * MiB, OFF_PB = 72 * MiB, PB_BYTES = 16 * MiB, OFF_XB0 = 104 * MiB, OFF_SSQ = 168 * MiB, SSQ_BYTES = 2 * MiB,
                 OFF_ZB = 174 * MiB, OFF_YI = 350 * MiB, OFF_MG = 382 * MiB, OFF_TG = 446 * MiB, OFF_MO = 470 * MiB, OFF_S = 478 * MiB, OFF_H = 494 * MiB,
                 OFF_VT = 510 * MiB, OFF_KT = 518 * MiB, OFF_AL = 522 * MiB, OFF_BIAS = 522 * MiB + 65536, OFF_GT = 523 * MiB, OFF_BAR = 528 * MiB;
constexpr size_t W_IN = 0, W_G = 2883584, W_GLU = 6029312, W_BR = 6291456, W_OUT = 7864320, W_FFI = 8912896, W_FFO = 14680064, W_PG = 17563648, W_PP = 18612224;

struct Params {
    const float *x, *p, *rel_bias, *norm_mix, *w_in, *lam_re, *lam_im, *b_re, *b_im, *c_re, *c_im, *ssm_d, *log_dt, *w_glu, *conv_w, *sinks, *w_branch, *w_out,
        *norm_ffn, *w_ffn_in, *w_ffn_out, *norm_ple, *w_ple_gate, *w_ple_proj, *norm_final;
    float* out; unsigned char* ws;
};

__device__ __forceinline__ int ltid() { int t = threadIdx.x; asm volatile("" : "+v"(t)); return t; }
__device__ __forceinline__ unsigned cvt_pk_bf16(float lo, float hi) { unsigned r; asm volatile("v_cvt_pk_bf16_f32 %0, %1, %2" : "=v"(r) : "v"(lo), "v"(hi)); return r; }
__device__ __forceinline__ float bf_lo(unsigned w) { return __uint_as_float(w << 16); }
__device__ __forceinline__ float bf_hi(unsigned w) { return __uint_as_float(w & 0xffff0000u); }
__device__ __forceinline__ float sigmoidf_(float v) { return __builtin_amdgcn_rcpf(1.0f + __expf(-v)); }
__device__ __forceinline__ float gelu_tanh(float y) { const float z = 1.5957691216057308f * (y + 0.044715f * y * y * y); return y * sigmoidf_(z); }
__device__ __forceinline__ u32x4 pack8(const f32x4 a, const f32x4 b) { u32x4 w; w.x = cvt_pk_bf16(a[0], a[1]); w.y = cvt_pk_bf16(a[2], a[3]); w.z = cvt_pk_bf16(b[0], b[1]); w.w = cvt_pk_bf16(b[2], b[3]); return w; }
__device__ __forceinline__ void unpack8(const u32x4 w, f32x4& a, f32x4& b) { a[0] = bf_lo(w.x); a[1] = bf_hi(w.x); a[2] = bf_lo(w.y); a[3] = bf_hi(w.y); b[0] = bf_lo(w.z); b[1] = bf_hi(w.z); b[2] = bf_lo(w.w); b[3] = bf_hi(w.w); }
__device__ __forceinline__ unsigned pack4_u8(const f32x4 v) { const unsigned q0 = (unsigned)(v[0] * 255.0f + 0.5f), q1 = (unsigned)(v[1] * 255.0f + 0.5f), q2 = (unsigned)(v[2] * 255.0f + 0.5f), q3 = (unsigned)(v[3] * 255.0f + 0.5f);
    return q0 | (q1 << 8) | (q2 << 16) | (q3 << 24); }
__device__ __forceinline__ unsigned pack4_u8c(const f32x4 v) { const unsigned q0 = (unsigned)fmaxf(v[0] * 255.0f + 0.5f, 1.0f), q1 = (unsigned)fmaxf(v[1] * 255.0f + 0.5f, 1.0f), q2 = (unsigned)fmaxf(v[2] * 255.0f + 0.5f, 1.0f), q3 = (unsigned)fmaxf(v[3] * 255.0f + 0.5f, 1.0f);
    return q0 | (q1 << 8) | (q2 << 16) | (q3 << 24); }
__device__ __forceinline__ f32x4 unpack4_raw(const unsigned w) { f32x4 v; v[0] = (float)(w & 0xffu); v[1] = (float)((w >> 8) & 0xffu); v[2] = (float)((w >> 16) & 0xffu); v[3] = (float)(w >> 24); return v; }
__device__ __forceinline__ f32x4 unpack4_u8(const unsigned w) { f32x4 v; v[0] = (float)(w & 0xffu); v[1] = (float)((w >> 8) & 0xffu); v[2] = (float)((w >> 16) & 0xffu); v[3] = (float)(w >> 24); return v * (1.0f / 255.0f); }
__device__ __forceinline__ float row_rs(const float* ssq, int row) {
    float s = 0.f;
#pragma unroll
    for (int pn = 0; pn < 4; ++pn)
#pragma unroll
        for (int j = 0; j < 4; ++j) s += __uint_as_float(__hip_atomic_load((unsigned*)(ssq + ((size_t)pn * T_TOK + row) * 4 + j), __ATOMIC_RELAXED, __HIP_MEMORY_SCOPE_AGENT));
    return rsqrtf(s * (1.0f / 1024.0f) + 1e-6f);
}

constexpr int BM = 256, BK = 64, HALF = 128, HTB = HALF * BK * 2, STAGE_BYTES = 8 * HTB;
__device__ __forceinline__ int lds_byte(int r, int c) { const int st = (r >> 4) * 2 + (c >> 5), rr = r & 15, cc = c & 31, ob = rr * 64 + cc * 2; return st * 1024 + (ob ^ (((ob >> 9) & 1) << 5)); }
__device__ __forceinline__ void stage_rc(int b, int& R, int& C) { const int st = b / 1024, sb = b % 1024, swz = sb ^ (((sb >> 9) & 1) << 5); R = (st >> 1) * 16 + swz / 64; C = (st & 1) * 32 + (swz % 64) / 2; }
__device__ __forceinline__ int perm32(int rho) { const int n = rho >> 4, i = rho & 15; return 8 * (i >> 2) + 4 * n + (i & 3); }

enum { K_WIN = 0, K_SSM1, K_SSM2, K_GLU, K_MG_G, K_MG_B, K_XADD, K_FFI, K_PP, K_PLE };
enum { PH_WIN = 0, PH_SSM1, PH_SSM2, PH_GLU, PH_MERGE, PH_WOUT, PH_FFI, PH_FFO, PH_PLE };

struct Unit {
    const char* A; const char* B;
    int pm, pn, aux, ord;
};
struct Shape { unsigned rsA, ssA, Kb; int nt, kind; };
template <int PH, int SUB> __device__ __forceinline__ constexpr Shape shape_of() {
    switch (PH) {
    case PH_WIN: return Shape{2048u, 32u, 1024u, 16, K_WIN};
    case PH_SSM1: return Shape{(unsigned)(LCH * 32), 32u, 512u, 8, K_SSM1};
    case PH_SSM2: return Shape{32u * 256u * 2u, 32u, 256u, 4, K_SSM2};
    case PH_GLU: return Shape{32u, (unsigned)(T_TOK * 32), 512u, 8, K_GLU};
    case PH_MERGE: return (SUB & 1) == 0 ? Shape{2048u, 32u, 1024u, 16, K_MG_G} : Shape{(unsigned)(ZW * 2), 32u, 512u, 8, K_MG_B};
    case PH_WOUT: return Shape{2048u, 32u, 1024u, 16, K_XADD};
    case PH_FFI: return Shape{2048u, 32u, 1024u, 16, K_FFI};
    case PH_FFO: return Shape{(unsigned)(ZW * 2), 32u, (unsigned)FFH, 44, K_XADD};
    default: return SUB == 0 ? Shape{512u, 32u, 256u, 4, K_PP} : Shape{2048u, 32u, 1024u, 16, K_PLE};
    }
}

__device__ __forceinline__ void tile_map(int wgid, int nM, int nN, int& pm, int& pn) {
    const int nwg = nM * nN; { const int q = nwg / 8, r = nwg % 8, xcd = wgid % 8, off = wgid / 8; wgid = (xcd < r ? xcd * (q + 1) : r * (q + 1) + (xcd - r) * q) + off; }
    const int nig = 8 * nN, gid = wgid / nig, fm = gid * 8, gsz = (nM - fm) < 8 ? (nM - fm) : 8;
    pm = fm + ((wgid % nig) % gsz); pn = (wgid % nig) / gsz;
}

template <int PH, int SUB> __device__ __forceinline__ bool sched_next(unsigned char* ws, int layer, int i, Unit& u, const void* ug = nullptr) {
    const int G = gridDim.x, c = blockIdx.x;
    const char* wb = (const char*)ws + OFF_WB + (size_t)(layer & 1) * WB_BYTES;
    const char* xb0 = (const char*)ws + OFF_XB0; const char* zb = (const char*)ws + OFF_ZB; const char* mg = (const char*)ws + OFF_MG;
    u.aux = 0; u.ord = i;
    if constexpr (PH == PH_WIN) { const int L = i * G + c; if (L >= 128 * 11) return false; tile_map(L, 128, 11, u.pm, u.pn);
        u.A = xb0 + (size_t)u.pm * 256 * 2048; u.B = wb + W_IN * 2 + (size_t)u.pn * 256 * 2048; return true; }
    if constexpr (PH == PH_SSM1) { const int L = i * G + c; if (L >= 384) return false; const int g = L / 12, rem = L % 12; u.pm = rem / 3; u.pn = rem % 3; u.aux = g;
        u.A = (const char*)ug + ((size_t)g * T_TOK + (size_t)u.pm * 256 * LCH) * 32; u.B = (const char*)ws + OFF_TG + ((size_t)g * 768 + u.pn * 256) * 512 * 2; return true; }
    if constexpr (PH == PH_SSM2) { const int L = i * G + c; if (L >= 256) return false; const int g = L / 8; u.pm = (L % 8) / 2; u.pn = L % 2; u.aux = g;
        u.A = (const char*)ws + OFF_H + ((size_t)u.pm * 256 * 32 + g) * 256 * 2; u.B = (const char*)ws + OFF_MO + ((size_t)g * 512 + u.pn * 256) * 256 * 2; return true; }
    if constexpr (PH == PH_GLU) { const int L = i * G + c; if (L >= 256) return false; tile_map(L, 128, 2, u.pm, u.pn);
        u.A = (const char*)ws + OFF_YI + (size_t)u.pm * 256 * 32; u.B = wb + W_GLU * 2 + (size_t)u.pn * 256 * 512 * 2; return true; }
    if constexpr (PH == PH_MERGE) { const int ui = i / 3, r = i % 3, L = ui * G + c; if (L >= 512) return false; tile_map(L, 128, 4, u.pm, u.pn); u.aux = r; u.ord = ui;
        if constexpr ((SUB & 1) == 0) { u.A = xb0 + (size_t)u.pm * 256 * 2048; u.B = wb + W_G * 2 + ((size_t)r * 1024 + u.pn * 256) * 2048; }
        else { u.A = zb + ((size_t)u.pm * 256 * ZW + (r == 0 ? 1024 : (r == 1 ? 512 : 2048))) * 2; u.B = wb + W_BR * 2 + ((size_t)r * 1024 + u.pn * 256) * 1024; }
        return true; }
    if constexpr (PH == PH_WOUT) { const int L = i * G + c; if (L >= 512) return false; tile_map(L, 128, 4, u.pm, u.pn);
        u.A = mg + (size_t)u.pm * 256 * 2048; u.B = wb + W_OUT * 2 + (size_t)u.pn * 256 * 2048; return true; }
    if constexpr (PH == PH_FFI) { const int L = i * G + c; if (L >= 128 * 22) return false; tile_map(L, 128, 22, u.pm, u.pn);
        u.A = xb0 + (size_t)u.pm * 256 * 2048; u.B = wb + W_FFI * 2 + (size_t)u.pn * 256 * 2048; return true; }
    if constexpr (PH == PH_FFO) { const int L = i * G + c; if (L >= 512) return false; tile_map(L, 128, 4, u.pm, u.pn); u.aux = 1;
        u.A = zb + (size_t)u.pm * 256 * ZW * 2; u.B = wb + W_FFO * 2 + (size_t)u.pn * 256 * FFH * 2; return true; }
    if constexpr (PH == PH_PLE) { const int L = i * G + c; if (L >= 512) return false; tile_map(L, 128, 4, u.pm, u.pn);
        if constexpr (SUB == 0) { u.A = (const char*)ws + OFF_PB + (size_t)(layer & 1) * PB_BYTES + (size_t)u.pm * 256 * 512; u.B = wb + W_PP * 2 + (size_t)u.pn * 256 * 512; }
        else { u.A = mg + (size_t)u.pm * 256 * 2048; u.B = wb + W_PG * 2 + (size_t)u.pn * 256 * 2048; }
        return true; }
    return false;
}

#define MEMFENCE asm volatile("" ::: "memory")
struct Epi {
    unsigned char* ws; float* x; const float* dskip; int layer; const LAS float* rstab;
    __device__ __forceinline__ void load_rs(const float* ssq, int rbase, int fq, float (&rs)[8]) const {
        f32x4 q[8];
#pragma unroll
        for (int r8 = 0; r8 < 8; ++r8) q[r8] = *(const f32x4*)(ssq + (size_t)(rbase + (r8 >> 2) * 128 + (r8 & 3) * 16) * 16 + fq * 4);
#pragma unroll
        for (int r8 = 0; r8 < 8; ++r8) { float t = (q[r8][0] + q[r8][1]) + (q[r8][2] + q[r8][3]); t += __shfl_xor(t, 16); t += __shfl_xor(t, 32); rs[r8] = rsqrtf(t * (1.0f / 1024.0f) + 1e-6f); }
    }
    __device__ __forceinline__ void get_rs(const Unit& u, int wr, int fr, float (&rs)[8]) const {
#pragma unroll
        for (int r8 = 0; r8 < 8; ++r8) rs[r8] = rstab[u.ord * 256 + (r8 >> 2) * 128 + wr * 64 + (r8 & 3) * 16 + fr];
    }
    template <int KIND> __device__ __forceinline__ void run(f32x4 (&acc)[2][2][4][2], const Unit& u, int tid_in) const {
        int tid = tid_in; asm volatile("" : "+v"(tid));
        const int wid = __builtin_amdgcn_readfirstlane(tid >> 6), lane = tid & 63, wr = wid >> 2, wc = wid & 3, fr = lane & 15, fq = lane >> 4;
        bf16_t* zb = (bf16_t*)(ws + OFF_ZB); bf16_t* yi = (bf16_t*)(ws + OFF_YI); bf16_t* mg = (bf16_t*)(ws + OFF_MG); bf16_t* xb0 = (bf16_t*)(ws + OFF_XB0);
        float* ssq0 = (float*)(ws + OFF_SSQ); float* ssq1 = (float*)(ws + OFF_SSQ + SSQ_BYTES); float* ssq2 = (float*)(ws + OFF_SSQ + 2 * SSQ_BYTES);
        u32x4* scr = (u32x4*)(ws + OFF_TG + ((size_t)blockIdx.x * 2 + (u.ord & 1)) * 131072);
        const int rbase = u.pm * 256 + wr * 64 + fr, cl = wc * 32 + fq * 8;
        if constexpr (KIND == K_WIN) { float rs[8]; get_rs(u, wr, fr, rs);
#pragma unroll
            for (int ai = 0; ai < 2; ++ai)
#pragma unroll
                for (int m = 0; m < 4; ++m) { int row = rbase + ai * 128 + m * 16; asm volatile("" : "+v"(row)); const float r = rs[ai * 4 + m];
                    if (u.pn >= 4 && u.pn < 8) {
                        const f32x4 v0 = (acc[ai][0][m][0] * r) * (acc[ai][1][m][0] * r), v1 = (acc[ai][0][m][1] * r) * (acc[ai][1][m][1] * r);
                        *(u32x4*)(zb + (size_t)row * ZW + 1024 + (u.pn - 4) * 128 + cl) = pack8(v0, v1); }
                    else
#pragma unroll
                    for (int bj = 0; bj < 2; ++bj) { const u32x4 w = pack8(acc[ai][bj][m][0] * r, acc[ai][bj][m][1] * r);
                        if (u.pn < 2) { const int col = u.pn * 256 + bj * 128 + cl; *(u32x4*)((bf16_t*)x + ((size_t)(col >> 4) * T_TOK + row) * 16 + (col & 15)) = w; }
                        else if (u.pn < 10 || bj == 0) *(u32x4*)(zb + (size_t)row * ZW + u.pn * 256 + bj * 128 + cl) = w;
                        else { const int b = row >> 13, s = row & 8191; bf16_t* vp = (bf16_t*)(ws + OFF_VT) + ((size_t)(b * 128 + cl)) * SEQ + s;
                            vp[0 * SEQ] = (bf16_t)(w.x & 0xffff); vp[1 * SEQ] = (bf16_t)(w.x >> 16); vp[2 * SEQ] = (bf16_t)(w.y & 0xffff); vp[3 * SEQ] = (bf16_t)(w.y >> 16);
                            vp[4 * SEQ] = (bf16_t)(w.z & 0xffff); vp[5 * SEQ] = (bf16_t)(w.z >> 16); vp[6 * SEQ] = (bf16_t)(w.w & 0xffff); vp[7 * SEQ] = (bf16_t)(w.w >> 16); } } MEMFENCE; }
        }
        if constexpr (KIND == K_SSM1) { const int g = u.aux;
#pragma unroll
            for (int ai = 0; ai < 2; ++ai)
#pragma unroll
                for (int m = 0; m < 4; ++m) { int R = rbase + ai * 128 + m * 16; asm volatile("" : "+v"(R));
                    if (u.pn < 2) {
#pragma unroll
                        for (int bj = 0; bj < 2; ++bj) { const int t = 16 * u.pn + 8 * bj + 2 * wc + (fq >> 1), p0 = 8 * (fq & 1);
                            *(u32x4*)(yi + ((size_t)g * T_TOK + (size_t)(R * LCH + t)) * 16 + p0) = pack8(acc[ai][bj][m][0], acc[ai][bj][m][1]); }
                    } else { float* sp = (float*)(ws + OFF_S) + ((size_t)(R * 32 + g)) * 128 + cl; *(f32x4*)sp = acc[ai][0][m][0]; *(f32x4*)(sp + 4) = acc[ai][0][m][1]; } }
        }
        if constexpr (KIND == K_SSM2) { const int g = u.aux; const int ch = g * 16 + 8 * (fq & 1); const f32x4 d0 = *(const f32x4*)(dskip + ch), d1 = *(const f32x4*)(dskip + ch + 4);
#pragma unroll
            for (int ai = 0; ai < 2; ++ai)
#pragma unroll
                for (int mh = 0; mh < 2; ++mh) { u32x4 yv[2][2], uv[2][2];
#pragma unroll
                    for (int ml = 0; ml < 2; ++ml) { int R = rbase + ai * 128 + (mh * 2 + ml) * 16; asm volatile("" : "+v"(R));
#pragma unroll
                        for (int bj = 0; bj < 2; ++bj) { const int t = 16 * u.pn + 8 * bj + 2 * wc + (fq >> 1); const size_t tok = (size_t)R * LCH + t;
                            yv[ml][bj] = *(const u32x4*)(yi + ((size_t)g * T_TOK + tok) * 16 + 8 * (fq & 1)); uv[ml][bj] = *(const u32x4*)((const bf16_t*)x + ((size_t)g * T_TOK + tok) * 16 + 8 * (fq & 1)); } }
#pragma unroll
                    for (int ml = 0; ml < 2; ++ml) { const int m = mh * 2 + ml; int R = rbase + ai * 128 + m * 16; asm volatile("" : "+v"(R));
#pragma unroll
                        for (int bj = 0; bj < 2; ++bj) { const int t = 16 * u.pn + 8 * bj + 2 * wc + (fq >> 1); const size_t tok = (size_t)R * LCH + t;
                            f32x4 y0, y1, u0, u1; unpack8(yv[ml][bj], y0, y1); unpack8(uv[ml][bj], u0, u1);
                            y0 = acc[ai][bj][m][0] + y0 + d0 * u0; y1 = acc[ai][bj][m][1] + y1 + d1 * u1;
#pragma unroll
                            for (int j = 0; j < 4; ++j) { y0[j] = gelu_tanh(y0[j]); y1[j] = gelu_tanh(y1[j]); }
                            *(u32x4*)(yi + ((size_t)g * T_TOK + tok) * 16 + 8 * (fq & 1)) = pack8(y0, y1); } }
                    MEMFENCE; }
        }
        if constexpr (KIND == K_GLU) { u32x4 yv[2][4][2];
#pragma unroll
            for (int ai = 0; ai < 2; ++ai)
#pragma unroll
                for (int m = 0; m < 4; ++m) { int row = rbase + ai * 128 + m * 16; asm volatile("" : "+v"(row));
#pragma unroll
                    for (int bj = 0; bj < 2; ++bj) { const int col = u.pn * 256 + bj * 128 + cl; yv[ai][m][bj] = *(const u32x4*)(yi + ((size_t)(col >> 4) * T_TOK + row) * 16 + (col & 15)); } }
#pragma unroll
            for (int ai = 0; ai < 2; ++ai)
#pragma unroll
                for (int m = 0; m < 4; ++m) { int row = rbase + ai * 128 + m * 16; asm volatile("" : "+v"(row));
#pragma unroll
                    for (int bj = 0; bj < 2; ++bj) { const int col = u.pn * 256 + bj * 128 + cl; f32x4 y0, y1; unpack8(yv[ai][m][bj], y0, y1);
#pragma unroll
                        for (int j = 0; j < 4; ++j) { y0[j] *= sigmoidf_(acc[ai][bj][m][0][j]); y1[j] *= sigmoidf_(acc[ai][bj][m][1][j]); }
                        *(u32x4*)(zb + (size_t)row * ZW + 1024 + col) = pack8(y0, y1); }
                    MEMFENCE; }
        }
        if constexpr (KIND == K_MG_G) { float rs[8]; get_rs(u, wr, fr, rs);
            u32x4* gst = (u32x4*)((unsigned char*)x + 32 * MiB) + ((size_t)(blockIdx.x * 2 + (u.ord & 1)) * 3 + u.aux) * 4096;
#pragma unroll
            for (int ai = 0; ai < 2; ++ai)
#pragma unroll
                for (int m = 0; m < 4; ++m) { const float r = rs[ai * 4 + m]; u32x4 w;
#pragma unroll
                    for (int bj = 0; bj < 2; ++bj) { f32x4 a = acc[ai][bj][m][0] * r, b = acc[ai][bj][m][1] * r;
#pragma unroll
                        for (int j = 0; j < 4; ++j) { a[j] = sigmoidf_(a[j]); b[j] = sigmoidf_(b[j]); }
                        if (bj == 0) { w.x = pack4_u8c(a); w.y = pack4_u8c(b); } else { w.z = pack4_u8c(a); w.w = pack4_u8c(b); } }
                    gst[(ai * 4 + m) * 512 + tid] = w; MEMFENCE; }
        }
        if constexpr (KIND == K_PP) {
#pragma unroll
            for (int ai = 0; ai < 2; ++ai)
#pragma unroll
                for (int m = 0; m < 4; ++m)
#pragma unroll
                    for (int bj = 0; bj < 2; ++bj) { scr[((ai * 4 + m) * 2 + bj) * 512 + tid] = pack8(acc[ai][bj][m][0], acc[ai][bj][m][1]); if (bj == 1) MEMFENCE; }
        }
        if constexpr (KIND == K_MG_B) { const int r = u.aux;
            const u32x4* gst = (const u32x4*)((unsigned char*)x + 32 * MiB) + ((size_t)(blockIdx.x * 2 + (u.ord & 1)) * 3) * 4096;
#pragma unroll
            for (int ai = 0; ai < 2; ++ai)
#pragma unroll
                for (int mh = 0; mh < 2; ++mh) { u32x4 qa[2], qb[2];
#pragma unroll
                    for (int ml = 0; ml < 2; ++ml) { const int m = mh * 2 + ml; qa[ml] = gst[(size_t)r * 4096 + (ai * 4 + m) * 512 + tid]; qb[ml] = (r < 2) ? gst[(size_t)(r + 1) * 4096 + (ai * 4 + m) * 512 + tid] : qa[ml]; }
#pragma unroll
                    for (int ml = 0; ml < 2; ++ml) { const int m = mh * 2 + ml; int row = rbase + ai * 128 + m * 16; asm volatile("" : "+v"(row));
#pragma unroll
                        for (int bj = 0; bj < 2; ++bj) {
                            const f32x4 n0 = unpack4_raw(bj == 0 ? qa[ml].x : qa[ml].z), n1 = unpack4_raw(bj == 0 ? qa[ml].y : qa[ml].w);
                            if (r < 2) { const f32x4 d0 = unpack4_raw(bj == 0 ? qb[ml].x : qb[ml].z), d1 = unpack4_raw(bj == 0 ? qb[ml].y : qb[ml].w);
#pragma unroll
                                for (int j = 0; j < 4; ++j) { acc[ai][bj][m][0][j] *= n0[j] * __builtin_amdgcn_rcpf(d0[j]); acc[ai][bj][m][1][j] *= n1[j] * __builtin_amdgcn_rcpf(d1[j]); } }
                            else { const f32x4 o0 = acc[ai][bj][m][0] * n0 * (1.0f / 255.0f), o1 = acc[ai][bj][m][1] * n1 * (1.0f / 255.0f);
                                *(u32x4*)(mg + (size_t)row * 1024 + u.pn * 256 + bj * 128 + cl) = pack8(o0, o1); } } }
                    MEMFENCE; }
        }
        if constexpr (KIND == K_XADD) {
            const bf16_t* xsrc = xb0; bf16_t* xbo = (u.aux ? mg : xb0); float* sso = (u.aux ? ssq2 : ssq1);
            u32x4 xv[2][2][2];
#define XLOAD(gi, bufi) do { _Pragma("unroll") for (int ml = 0; ml < 2; ++ml) { const int m_ = ((gi) & 1) * 2 + ml; int row_ = rbase + ((gi) >> 1) * 128 + m_ * 16; asm volatile("" : "+v"(row_)); \
                _Pragma("unroll") for (int bj = 0; bj < 2; ++bj) xv[bufi][ml][bj] = *(const u32x4*)(xsrc + (size_t)row_ * 1024 + u.pn * 256 + bj * 128 + cl); } } while (0)
            XLOAD(0, 0);
#pragma unroll
            for (int gi = 0; gi < 4; ++gi) { const int ai = gi >> 1, mh = gi & 1, bufi = gi & 1;
                if (gi < 3) XLOAD(gi + 1, (gi + 1) & 1);
#pragma unroll
                for (int ml = 0; ml < 2; ++ml) { const int m = mh * 2 + ml; int row = rbase + ai * 128 + m * 16; asm volatile("" : "+v"(row)); float ss = 0.f;
#pragma unroll
                    for (int bj = 0; bj < 2; ++bj) { const size_t off = (size_t)row * 1024 + u.pn * 256 + bj * 128 + cl; f32x4 x0, x1; unpack8(xv[bufi][ml][bj], x0, x1);
                        const f32x4 o0 = x0 + acc[ai][bj][m][0], o1 = x1 + acc[ai][bj][m][1];
                        *(u32x4*)(xbo + off) = pack8(o0, o1);
                        ss += (o0[0] * o0[0] + o0[1] * o0[1]) + (o0[2] * o0[2] + o0[3] * o0[3]) + (o1[0] * o1[0] + o1[1] * o1[1]) + (o1[2] * o1[2] + o1[3] * o1[3]); }
                    ss += __shfl_xor(ss, 16); ss += __shfl_xor(ss, 32);
                    if (fq == 0) sso[((size_t)u.pn * T_TOK + row) * 4 + wc] = ss; }
                MEMFENCE; }
#undef XLOAD
        }
        if constexpr (KIND == K_PLE) {
            const bf16_t* xsrc = mg; float rs[8]; get_rs(u, wr, fr, rs);
#pragma unroll
            for (int ai = 0; ai < 2; ++ai)
#pragma unroll
                for (int mh = 0; mh < 2; ++mh) { u32x4 xv[2][2], pv[2][2];
#pragma unroll
                    for (int ml = 0; ml < 2; ++ml) { const int m = mh * 2 + ml; int row = rbase + ai * 128 + m * 16; asm volatile("" : "+v"(row));
#pragma unroll
                        for (int bj = 0; bj < 2; ++bj) { xv[ml][bj] = *(const u32x4*)(xsrc + (size_t)row * 1024 + u.pn * 256 + bj * 128 + cl); pv[ml][bj] = scr[((ai * 4 + m) * 2 + bj) * 512 + tid]; } }
#pragma unroll
                    for (int ml = 0; ml < 2; ++ml) { const int m = mh * 2 + ml; int row = rbase + ai * 128 + m * 16; asm volatile("" : "+v"(row)); float ss = 0.f; const float r = rs[ai * 4 + m];
#pragma unroll
                        for (int bj = 0; bj < 2; ++bj) { const size_t off = (size_t)row * 1024 + u.pn * 256 + bj * 128 + cl; f32x4 a = acc[ai][bj][m][0], b = acc[ai][bj][m][1], p0, p1, x0, x1;
                            unpack8(pv[ml][bj], p0, p1); unpack8(xv[ml][bj], x0, x1);
#pragma unroll
                            for (int j = 0; j < 4; ++j) { a[j] = sigmoidf_(a[j] * r) * p0[j]; b[j] = sigmoidf_(b[j] * r) * p1[j]; }
                            const f32x4 o0 = x0 + a, o1 = x1 + b;
                            *(u32x4*)(xb0 + off) = pack8(o0, o1);
                            ss += (o0[0] * o0[0] + o0[1] * o0[1]) + (o0[2] * o0[2] + o0[3] * o0[3]) + (o1[0] * o1[0] + o1[1] * o1[1]) + (o1[2] * o1[2] + o1[3] * o1[3]); }
                        ss += __shfl_xor(ss, 16); ss += __shfl_xor(ss, 32);
                        if (fq == 0) ssq0[((size_t)u.pn * T_TOK + row) * 4 + wc] = ss; }
                    MEMFENCE; }
        }
        if constexpr (KIND == K_FFI) { bf16_t* act = zb; float rs[8]; get_rs(u, wr, fr, rs);
#pragma unroll
            for (int ai = 0; ai < 2; ++ai)
#pragma unroll
                for (int m = 0; m < 4; ++m) { int row = rbase + ai * 128 + m * 16; asm volatile("" : "+v"(row)); const float r = rs[ai * 4 + m]; f32x4 o[2];
#pragma unroll
                    for (int n = 0; n < 2; ++n) { const f32x4 g = acc[ai][0][m][n] * r, v = acc[ai][1][m][n] * r;
#pragma unroll
                        for (int j = 0; j < 4; ++j) o[n][j] = g[j] * sigmoidf_(g[j]) * v[j]; }
                    *(u32x4*)(act + (size_t)row * ZW + u.pn * 128 + cl) = pack8(o[0], o[1]); MEMFENCE; }
        }
    }
};


template <int PH, int SUB> __device__ __forceinline__ void rs_fill(LAS unsigned char* lds, const Epi& E) {
    constexpr int kind = shape_of<PH, SUB>().kind;
    if constexpr ((kind == K_WIN || kind == K_MG_G || kind == K_FFI || kind == K_PLE) && !(PH == PH_MERGE && SUB != 0)) {
        const int tidx = ltid();
        const float* ssq = (const float*)(E.ws + OFF_SSQ + (kind == K_FFI ? SSQ_BYTES : (kind == K_PLE ? 2 * SSQ_BYTES : 0)));
        LAS float* tab = (LAS float*)(lds + STAGE_BYTES + 16);
        for (int i = 0; i < 12; ++i) { Unit u; if (!sched_next<PH, SUB>(E.ws, E.layer, i, u)) break;
            const int r = tidx >> 1, hf = tidx & 1; const size_t row = (size_t)(u.pm * 256 + r); f32x4 a, b;
            { unsigned* pa = (unsigned*)(ssq + ((size_t)(2 * hf) * T_TOK + row) * 4); unsigned* pb = (unsigned*)(ssq + ((size_t)(2 * hf + 1) * T_TOK + row) * 4);
#pragma unroll
              for (int j = 0; j < 4; ++j) { a[j] = __uint_as_float(__hip_atomic_load(pa + j, __ATOMIC_RELAXED, __HIP_MEMORY_SCOPE_AGENT)); b[j] = __uint_as_float(__hip_atomic_load(pb + j, __ATOMIC_RELAXED, __HIP_MEMORY_SCOPE_AGENT)); } }
            float t = ((a[0] + a[1]) + (a[2] + a[3])) + ((b[0] + b[1]) + (b[2] + b[3])); t += __shfl_xor(t, 1);
            if (hf == 0) tab[u.ord * 256 + r] = rsqrtf(t * (1.0f / 1024.0f) + 1e-6f); }
        __syncthreads();
    }
}
template <int PH, int SUB = 0> __device__ __forceinline__ void gemm_phase(LAS unsigned char* lds, const Epi& E) {
    rs_fill<PH, SUB>(lds, E);
    int tid = threadIdx.x; asm volatile("" : "+v"(tid));
    const int wid = __builtin_amdgcn_readfirstlane(tid >> 6), lane = tid & 63, wr = wid >> 2, wc = wid & 3, fr = lane & 15, fq = lane >> 4;
    int R0, C0; stage_rc(tid * 16, R0, C0);
    const unsigned Rb0 = (unsigned)((R0 & ~31) + perm32(R0 & 31)), c1 = (unsigned)(C0 >> 4), c0b = (unsigned)((C0 & 15) * 2);
    const unsigned ldsw = (unsigned)wid * 1024u;
    const int aoff = lds_byte(wr * 64 + fr, fq * 8), boff = lds_byte(wc * 32 + fr, fq * 8);
    constexpr Shape cs = shape_of<PH, SUB>();
    const unsigned cA0 = (unsigned)R0 * cs.rsA + c1 * cs.ssA + c0b, cB0 = (Rb0 * cs.Kb + (unsigned)C0) * 2u;
    constexpr size_t chA = (size_t)128 * cs.rsA, ckA = (size_t)4 * cs.ssA, chB = (size_t)256 * cs.Kb, qA = (size_t)64 * cs.rsA, qB = (size_t)128 * cs.Kb, kB = 128;
    constexpr int nt = cs.nt;
#define G_SA(b, h) (((b) * 2 + (h)) * HTB)
#define G_SB(b, h) ((4 + (b) * 2 + (h)) * HTB)
#define G_STAGE(bufoff, gbase, o0, h64) do { \
        __builtin_amdgcn_global_load_lds((const unsigned*)((const char*)(gbase) + (o0)), (LAS unsigned*)(lds + (bufoff) + ldsw), 16, 0, 0); \
        __builtin_amdgcn_global_load_lds((const unsigned*)((const char*)(gbase) + (h64) + (o0)), (LAS unsigned*)(lds + (bufoff) + ldsw + 8192), 16, 0, 0); } while (0)
#define G_LDA(dst, b, h) do { _Pragma("unroll") for (int m = 0; m < 4; ++m) _Pragma("unroll") for (int k = 0; k < 2; ++k) dst[m][k] = *(const LAS bf16x8*)(lds + G_SA(b, h) + aoff + m * 2048 + k * 1024); } while (0)
#define G_LDB(dst, b, h) do { _Pragma("unroll") for (int n = 0; n < 2; ++n) _Pragma("unroll") for (int k = 0; k < 2; ++k) dst[n][k] = *(const LAS bf16x8*)(lds + G_SB(b, h) + boff + n * 2048 + k * 1024); } while (0)
#define G_MMA(ai, bj, At, Bt) do { __builtin_amdgcn_s_setprio(1); _Pragma("unroll") for (int m = 0; m < 4; ++m) _Pragma("unroll") for (int n = 0; n < 2; ++n) _Pragma("unroll") for (int k = 0; k < 2; ++k) \
        acc[ai][bj][m][n] = __builtin_amdgcn_mfma_f32_16x16x32_bf16(Bt[n][k], At[m][k], acc[ai][bj][m][n], 0, 0, 0); __builtin_amdgcn_s_setprio(0); } while (0)
#define G_WAIT_V(n) asm volatile("s_waitcnt vmcnt(" #n ")" ::: "memory")
#define G_WAIT_L(n) asm volatile("s_waitcnt lgkmcnt(" #n ")" ::: "memory")
#define G_BAR __builtin_amdgcn_s_barrier()
#define G_SCHED __builtin_amdgcn_sched_barrier(0)
    Unit cur, nxt; int ui = 0;
    if (!sched_next<PH, SUB>(E.ws, E.layer, 0, cur, E.x)) return;
    f32x4 acc[2][2][4][2];
#pragma unroll
    for (int a = 0; a < 2; ++a)
#pragma unroll
        for (int b = 0; b < 2; ++b)
#pragma unroll
            for (int m = 0; m < 4; ++m)
#pragma unroll
                for (int n = 0; n < 2; ++n) acc[a][b][m][n] = (f32x4){0.f, 0.f, 0.f, 0.f};
    bf16x8 At[4][2], B0[2][2], B1[2][2];
    const char* cA = cur.A; const char* cB = cur.B;
    G_STAGE(G_SB(0, 0), cB, cB0, qB); G_STAGE(G_SA(0, 0), cA, cA0, qA); G_STAGE(G_SB(0, 1), cB + chB, cB0, qB); G_STAGE(G_SA(0, 1), cA + chA, cA0, qA);
    if (wr == 1) G_BAR;
    G_WAIT_V(4); G_BAR;
    G_STAGE(G_SB(1, 0), cB + kB, cB0, qB); G_STAGE(G_SA(1, 0), cA + ckA, cA0, qA); G_STAGE(G_SB(1, 1), cB + chB + kB, cB0, qB);
    G_WAIT_V(6); G_BAR;
    for (;;) {
        const bool has_next = sched_next<PH, SUB>(E.ws, E.layer, ui + 1, nxt, E.x);
        if (!has_next) nxt = cur;
        const char* nA = nxt.A; const char* nB = nxt.B;
#pragma unroll 1
        for (int t = 0; t < nt; t += 2) {
            const bool last = (t == nt - 2);
            const char* a1 = cA + (size_t)(t + 1) * ckA;
            const char* a2 = last ? nA : cA + (size_t)(t + 2) * ckA; const char* b2 = last ? nB : cB + (size_t)(t + 2) * kB;
            const char* a3 = a2 + ckA; const char* b3 = b2 + kB;
            G_LDB(B0, 0, 0); G_SCHED; G_LDA(At, 0, 0); G_STAGE(G_SA(1, 1), a1 + chA, cA0, qA);
            G_WAIT_L(8); G_BAR; G_WAIT_L(0); G_MMA(0, 0, At, B0); G_BAR; G_SCHED;
            G_LDB(B1, 0, 1); G_STAGE(G_SB(0, 0), b2, cB0, qB);
            G_BAR; G_WAIT_L(0); G_MMA(0, 1, At, B1); G_BAR;
            G_LDA(At, 0, 1); G_STAGE(G_SA(0, 0), a2, cA0, qA);
            G_BAR; G_WAIT_L(0); G_MMA(1, 0, At, B0); G_BAR; G_SCHED;
            G_STAGE(G_SB(0, 1), b2 + chB, cB0, qB);
            G_WAIT_V(6); G_BAR; G_MMA(1, 1, At, B1); G_BAR;
            G_LDB(B0, 1, 0); G_SCHED; G_LDA(At, 1, 0); G_STAGE(G_SA(0, 1), a2 + chA, cA0, qA);
            G_WAIT_L(8); G_BAR; G_WAIT_L(0); G_MMA(0, 0, At, B0); G_BAR; G_SCHED;
            G_LDB(B1, 1, 1); G_STAGE(G_SB(1, 0), b3, cB0, qB);
            G_BAR; G_WAIT_L(0); G_MMA(0, 1, At, B1); G_BAR;
            G_LDA(At, 1, 1); G_STAGE(G_SA(1, 0), a3, cA0, qA);
            G_BAR; G_WAIT_L(0); G_MMA(1, 0, At, B0); G_BAR; G_SCHED;
            G_STAGE(G_SB(1, 1), b3 + chB, cB0, qB);
            G_WAIT_V(6); G_BAR; G_MMA(1, 1, At, B1); G_BAR;
        }
        E.template run<cs.kind>(acc, cur, tid);
        if (!has_next) break;
        if (!(cs.kind == K_MG_B && cur.aux < 2))
#pragma unroll
        for (int a = 0; a < 2; ++a)
#pragma unroll
            for (int b = 0; b < 2; ++b)
#pragma unroll
                for (int m = 0; m < 4; ++m)
#pragma unroll
                    for (int n = 0; n < 2; ++n) acc[a][b][m][n] = (f32x4){0.f, 0.f, 0.f, 0.f};
        cur = nxt; cA = nA; cB = nB; ++ui;
    }
    G_WAIT_V(0);
    if (wr == 0) G_BAR;
    G_BAR;
#undef G_SA
#undef G_SB
#undef G_STAGE
#undef G_LDA
#undef G_LDB
#undef G_MMA
#undef G_WAIT_V
#undef G_WAIT_L
#undef G_BAR
#undef G_SCHED
}

__device__ __forceinline__ void convert_job(unsigned char* smem, const float* src, int ld, int col0, int mapkind, int N, int K, const float* scale, bf16_t* dst, int vb, int vG) {
    const int tidx = ltid();
    bf16_t* tile = (bf16_t*)smem;
    const int w = tidx >> 6, lane = tidx & 63;
    const int tn = N / 64, tk = K / 256, ntile = tn * tk;
    for (int t = vb; t < ntile; t += vG) {
        const int n0 = (t % tn) * 64, k0 = (t / tn) * 256;
        const int np = n0 + lane; int sc;
        if (mapkind == 0) sc = col0 + np;
        else if (mapkind == 2) { if (np >= 1024 && np < 2048) { const int pq = (np - 1024) >> 8, c = np & 255; sc = (c < 128) ? (1024 + pq * 128 + c) : (1536 + pq * 128 + (c - 128)); } else sc = np; }
        else { const int pn = np >> 8, c = np & 255; sc = (c < 128) ? (pn * 128 + c) : (FFH + pn * 128 + (c - 128)); }
        float v[32];
#pragma unroll
        for (int rr = 0; rr < 32; ++rr) v[rr] = src[(size_t)(k0 + w * 32 + rr) * ld + sc];
        if (scale) {
#pragma unroll
            for (int rr = 0; rr < 32; ++rr) v[rr] *= scale[k0 + w * 32 + rr]; }
#pragma unroll
        for (int rr = 0; rr < 32; rr += 2) *(unsigned*)(tile + lane * 258 + w * 32 + rr) = cvt_pk_bf16(v[rr], v[rr + 1]);
        __syncthreads();
#pragma unroll
        for (int i = 0; i < 4; ++i) { const int idx = tidx + i * 512, nn = idx >> 5, k8 = idx & 31; const unsigned* tp = (const unsigned*)(tile + nn * 258 + k8 * 8); u32x4 o; o.x = tp[0]; o.y = tp[1]; o.z = tp[2]; o.w = tp[3];
            *(u32x4*)(dst + (size_t)(n0 + nn) * K + k0 + k8 * 8) = o; }
        __syncthreads();
    }
}
__device__ __forceinline__ void convert_layer(unsigned char* smem, const Params& P, int layer, int skip) {
    const int tidx = ltid();
    if ((int)blockIdx.x < skip) return;
    const int vb = blockIdx.x - skip, vG = gridDim.x - skip;
    bf16_t* wb = (bf16_t*)(P.ws + OFF_WB + (size_t)(layer & 1) * WB_BYTES);
    convert_job(smem, P.w_in + (size_t)layer * DM * INW, INW, 0, 2, ZW, DM, P.norm_mix + layer * DM, wb + W_IN, vb, vG);
    convert_job(smem, P.w_in + (size_t)layer * DM * INW, INW, ZW, 0, 3072, DM, P.norm_mix + layer * DM, wb + W_G, vb, vG);
    convert_job(smem, P.w_glu + (size_t)layer * 512 * 512, 512, 0, 0, 512, 512, nullptr, wb + W_GLU, vb, vG);
    for (int r = 0; r < 3; ++r) convert_job(smem, P.w_branch + ((size_t)layer * 3 + r) * 512 * 1024, 1024, 0, 0, 1024, 512, nullptr, wb + W_BR + (size_t)r * 1024 * 512, vb, vG);
    convert_job(smem, P.w_out + (size_t)layer * DM * DM, DM, 0, 0, DM, DM, nullptr, wb + W_OUT, vb, vG);
    convert_job(smem, P.w_ffn_in + (size_t)layer * DM * 2 * FFH, 2 * FFH, 0, 1, 2 * FFH, DM, P.norm_ffn + layer * DM, wb + W_FFI, vb, vG);
    convert_job(smem, P.w_ffn_out + (size_t)layer * FFH * DM, DM, 0, 0, DM, FFH, nullptr, wb + W_FFO, vb, vG);
    convert_job(smem, P.w_ple_gate + (size_t)layer * DM * DM, DM, 0, 0, DM, DM, P.norm_ple + layer * DM, wb + W_PG, vb, vG);
    convert_job(smem, P.w_ple_proj + (size_t)layer * 256 * DM, DM, 0, 0, DM, 256, nullptr, wb + W_PP, vb, vG);
    const f32x4* ps = (const f32x4*)(P.p + (size_t)layer * T_TOK * 256); u32x4* pd = (u32x4*)(P.ws + OFF_PB + (size_t)(layer & 1) * PB_BYTES);
    for (size_t i = (size_t)vb * 512 + tidx; i < (size_t)T_TOK * 256 / 8; i += (size_t)vG * 512) pd[i] = pack8(ps[2 * i], ps[2 * i + 1]);
}

__device__ __forceinline__ void a_pow(float lr, float li, float dt, int tau, float& re, float& im) {
    const float mag = __expf(lr * dt * (float)tau);
    double rev = (double)li * (double)dt * (double)tau * 0.15915494309189535; rev -= rint(rev);
    const double q = rint(rev * 4.0), th = (rev * 4.0 - q) * 1.5707963267948966, t2 = th * th;
    const double sn = th * (1.0 + t2 * (-1.0 / 6 + t2 * (1.0 / 120 + t2 * (-1.0 / 5040 + t2 * (1.0 / 362880 + t2 * (-1.0 / 39916800))))));
    const double cs = 1.0 + t2 * (-0.5 + t2 * (1.0 / 24 + t2 * (-1.0 / 720 + t2 * (1.0 / 40320 + t2 * (-1.0 / 3628800 + t2 * (1.0 / 479001600))))));
    const int qi = ((int)q) & 3; double c, s;
    if (qi == 0) { c = cs; s = sn; } else if (qi == 1) { c = -sn; s = cs; } else if (qi == 2) { c = -cs; s = -sn; } else { c = sn; s = -cs; }
    re = mag * (float)c; im = mag * (float)s;
}
__device__ __forceinline__ void ssm_group_tables(const Params& P, int layer, int g, int tau0, int ntau, float2* AT, float2* BB, float2* CC) {
    const int tidx = ltid();
    const int tid = tidx; const size_t gl = (size_t)layer * 32 + g;
    const float dt = __expf(P.log_dt[gl]);
    for (int i = tid; i < ntau * 64; i += 512) { const int tau = tau0 + i / 64, n = i % 64; float re, im; a_pow(P.lam_re[gl * 64 + n], P.lam_im[gl * 64 + n], dt, tau, re, im); AT[i] = make_float2(re, im); }
    for (int i = tid; i < 1024; i += 512) { const int n = i >> 4;
        const float lr = P.lam_re[gl * 64 + n], li = P.lam_im[gl * 64 + n]; float ar, ai; a_pow(lr, li, dt, 1, ar, ai);
        const float den = lr * lr + li * li, nr = ar - 1.0f, cr = (nr * lr + ai * li) / den, ci = (ai * lr - nr * li) / den;
        const float br = P.b_re[gl * 1024 + i], bi = P.b_im[gl * 1024 + i];
        BB[i] = make_float2(cr * br - ci * bi, cr * bi + ci * br);
        CC[i] = make_float2(P.c_re[gl * 1024 + i], P.c_im[gl * 1024 + i]); }
}
__device__ __forceinline__ void ssm_ktable(unsigned char* smem, const Params& P) {
    const int tidx = ltid();
    float2* AT = (float2*)smem; float2* BB = AT + 4 * 64; float2* CC = BB + 1024;
    float* Kt = (float*)(P.ws + OFF_KT);
    for (int job = blockIdx.x; job < N_LAYERS * 256; job += gridDim.x) { const int layer = job >> 8, g = (job >> 3) & 31, sub = job & 7;
        __syncthreads(); ssm_group_tables(P, layer, g, 4 * sub, 4, AT, BB, CC); __syncthreads();
        for (int i = tidx; i < 1024; i += 512) { const int tl = i >> 8, p = (i >> 4) & 15, q = i & 15; float s = 0.f;
            for (int n = 0; n < 64; ++n) { const float2 a = AT[tl * 64 + n], b = BB[n * 16 + q], c = CC[p * 64 + n]; const float wr_ = a.x * b.x - a.y * b.y, wi_ = a.x * b.y + a.y * b.x; s += c.x * wr_ - c.y * wi_; }
            Kt[((size_t)(layer * 32 + g) * 32 + 4 * sub + tl) * 256 + (i & 255)] = s; } }
}
__device__ __forceinline__ void ssm_group_tables_all(const Params& P) {
    for (int job = blockIdx.x; job < N_LAYERS * 32; job += gridDim.x) { float2* base = (float2*)(P.ws + OFF_GT) + (size_t)job * 4160;
        ssm_group_tables(P, job >> 5, job & 31, 0, 33, base, base + 33 * 64, base + 33 * 64 + 1024); }
}
__device__ __forceinline__ void ssm_tables(unsigned char* smem, const Params& P, int layer, int job0, int job1, int jstep) {
    const int tidx = ltid();
    float2* AT = (float2*)smem; float2* BB = AT + 33 * 64; float2* CC = BB + 1024;
    const float* Kt = (const float*)(P.ws + OFF_KT) + (size_t)layer * 32 * 8192; const int tid = tidx;
    for (int job = job0; job < job1; job += jstep) { const int g = job >> 3, sub = job & 7;
        __syncthreads(); { const float2* src = (const float2*)(P.ws + OFF_GT) + (size_t)(layer * 32 + g) * 4160; for (int i = tid; i < 4160; i += 512) AT[i] = src[i]; } __syncthreads();
        bf16_t* Tg = (bf16_t*)(P.ws + OFF_TG) + (size_t)g * 768 * 512; bf16_t* Mo = (bf16_t*)(P.ws + OFF_MO) + (size_t)g * 512 * 256; const float* Kg = Kt + (size_t)g * 8192;
        for (int i = tid; i < 64 * 64; i += 512) { const int rl = i >> 6, pc = i & 63, t = 4 * sub + (rl >> 4), p = rl & 15, s = pc >> 1, q0 = (pc & 1) * 8; u32x4 w = {0u, 0u, 0u, 0u};
            if (t >= s) { const float* kp = Kg + (size_t)(t - s) * 256 + p * 16 + q0; w = pack8(*(const f32x4*)kp, *(const f32x4*)(kp + 4)); }
            *(u32x4*)(Tg + (size_t)(t * 16 + p) * 512 + pc * 8) = w; }
        for (int i = tid; i < 16 * 64; i += 512) { const int np = 16 * sub + (i >> 6), pc = i & 63, n = np & 63, s = pc >> 1, q0 = (pc & 1) * 8; const float2 a = AT[(LCH - 1 - s) * 64 + n]; f32x4 v0, v1;
#pragma unroll
            for (int j = 0; j < 8; ++j) { const float2 b = BB[n * 16 + q0 + j]; const float val = (np < 64) ? (a.x * b.x - a.y * b.y) : (a.x * b.y + a.y * b.x); if (j < 4) v0[j] = val; else v1[j - 4] = val; }
            *(u32x4*)(Tg + (size_t)(512 + np) * 512 + pc * 8) = pack8(v0, v1);
            *(u32x4*)(Tg + (size_t)(640 + np) * 512 + pc * 8) = (u32x4){0u, 0u, 0u, 0u}; }
        for (int i = tid; i < 64 * 32; i += 512) { const int rl = i >> 5, pc = i & 31, t = 4 * sub + (rl >> 4), p = rl & 15; u32x4 w = {0u, 0u, 0u, 0u};
            if (pc < 16) { const int n0 = (pc & 7) * 8; f32x4 v0, v1;
#pragma unroll
                for (int j = 0; j < 8; ++j) { const float2 a = AT[(t + 1) * 64 + n0 + j], c = CC[p * 64 + n0 + j]; const float val = (pc < 8) ? (c.x * a.x - c.y * a.y) : -(c.x * a.y + c.y * a.x); if (j < 4) v0[j] = val; else v1[j - 4] = val; }
                w = pack8(v0, v1); }
            *(u32x4*)(Mo + (size_t)(t * 16 + p) * 256 + pc * 8) = w; }
        if (sub == 0 && tid < 64) ((float2*)(P.ws + OFF_AL))[g * 64 + tid] = AT[LCH * 64 + tid];
    }
}
__device__ __forceinline__ void ssm_scan(const Params& P) {
    const int tidx = ltid();
    const int gt = blockIdx.x * 512 + tidx; if (gt >= 8192) return;
    const int b = gt >> 11, g = (gt >> 6) & 31, n = gt & 63;
    float2 a; { unsigned* ap = (unsigned*)(P.ws + OFF_AL) + (g * 64 + n) * 2; a.x = __uint_as_float(__hip_atomic_load(ap, __ATOMIC_RELAXED, __HIP_MEMORY_SCOPE_AGENT)); a.y = __uint_as_float(__hip_atomic_load(ap + 1, __ATOMIC_RELAXED, __HIP_MEMORY_SCOPE_AGENT)); }
    const float* S = (const float*)(P.ws + OFF_S); bf16_t* H = (bf16_t*)(P.ws + OFF_H);
    float hr = 0.f, hi = 0.f;
    for (int c0 = 0; c0 < 256; c0 += 32) { float sr[32], si[32];
#pragma unroll
        for (int j = 0; j < 32; ++j) { const size_t o = ((size_t)(b * 256 + c0 + j) * 32 + g) * 128 + n; sr[j] = S[o]; si[j] = S[o + 64]; }
#pragma unroll
        for (int j = 0; j < 32; ++j) { bf16_t* hp = H + ((size_t)(b * 256 + c0 + j) * 32 + g) * 256 + n; const unsigned w = cvt_pk_bf16(hr, hi);
            hp[0] = (bf16_t)(w & 0xffff); hp[64] = (bf16_t)(w >> 16); hp[128] = 0; hp[192] = 0;
            const float nr = a.x * hr - a.y * hi + sr[j], ni = a.x * hi + a.y * hr + si[j]; hr = nr; hi = ni; } }
}

__device__ __forceinline__ void conv_phase(const Params& P, int layer) {
    const int tidx = ltid();
    bf16_t* zb = (bf16_t*)(P.ws + OFF_ZB); const float* cw = P.conv_w + (size_t)layer * 3 * 512;
    const int c8 = (tidx & 63) * 8;
    f32x4 w[3][2];
#pragma unroll
    for (int d = 0; d < 3; ++d) { w[d][0] = *(const f32x4*)(cw + d * 512 + c8); w[d][1] = *(const f32x4*)(cw + d * 512 + c8 + 4); }
    for (int run = blockIdx.x * 8 + (tidx >> 6); run < T_TOK / 16; run += gridDim.x * 8) {
        const size_t t0 = (size_t)run * 16; const int s0 = (int)(t0 & 8191);
        bf16_t* base = zb + t0 * ZW + c8;
        f32x4 v1[2] = {{0.f, 0.f, 0.f, 0.f}, {0.f, 0.f, 0.f, 0.f}}, v2[2] = {{0.f, 0.f, 0.f, 0.f}, {0.f, 0.f, 0.f, 0.f}};
        if (s0 > 0) { unpack8(*(const u32x4*)(base - (size_t)ZW + 1024), v1[0], v1[1]); unpack8(*(const u32x4*)(base - (size_t)2 * ZW + 1024), v2[0], v2[1]); }
#pragma unroll
        for (int q = 0; q < 4; ++q) { u32x4 cbv[4], vv[4];
#pragma unroll
            for (int j = 0; j < 4; ++j) { bf16_t* bp = base + (size_t)(q * 4 + j) * ZW; cbv[j] = *(const u32x4*)(bp + 512); vv[j] = *(const u32x4*)(bp + 1024); }
#pragma unroll
            for (int j = 0; j < 4; ++j) { f32x4 v00, v01, g0, g1; unpack8(vv[j], v00, v01); unpack8(cbv[j], g0, g1);
                const f32x4 y0 = g0 * (w[0][0] * v2[0] + w[1][0] * v1[0] + w[2][0] * v00), y1 = g1 * (w[0][1] * v2[1] + w[1][1] * v1[1] + w[2][1] * v01);
                *(u32x4*)(base + (size_t)(q * 4 + j) * ZW + 512) = pack8(y0, y1);
                v2[0] = v1[0]; v2[1] = v1[1]; v1[0] = v00; v1[1] = v01; } }
    }
}

__device__ __forceinline__ void attn_phase(unsigned char* smem, const Params& P, int layer) {
    const int tidx = ltid();
    bf16_t* Kl = (bf16_t*)smem;
    bf16_t* Vl = (bf16_t*)(smem + 256 * 72 * 2);
    float* Bl = (float*)(smem + 256 * 72 * 2 + 64 * 264 * 2);
    bf16_t* zb = (bf16_t*)(P.ws + OFF_ZB); const bf16_t* vT = (const bf16_t*)(P.ws + OFF_VT); const float* biasd = (const float*)(P.ws + OFF_BIAS);
    const int tid = tidx, w = tid >> 6, lane = tid & 63, ql = lane & 15, q4 = lane >> 4;
    for (int item = blockIdx.x; item < 512; item += gridDim.x) {
        const int b = item >> 7, blk = (item & 127) >> 1, kvh = item & 1, s0 = blk * 128;
        __syncthreads();
        for (int pc = tid; pc < 2048; pc += 512) { const int key = pc >> 3, d8 = pc & 7, s = s0 - 128 + key; u32x4 v = {0u, 0u, 0u, 0u};
            if (s >= 0) v = *(const u32x4*)(zb + ((size_t)(b * SEQ + s)) * ZW + 2560 + kvh * 64 + d8 * 8);
            *(u32x4*)(Kl + key * 72 + d8 * 8) = v; }
        for (int pc = tid; pc < 2048; pc += 512) { const int d = pc >> 5, k8 = pc & 31, s = s0 - 128 + k8 * 8; u32x4 v = {0u, 0u, 0u, 0u};
            if (s >= 0) v = *(const u32x4*)(vT + ((size_t)(b * 128 + kvh * 64 + d)) * SEQ + s);
            *(u32x4*)(Vl + d * 264 + k8 * 8) = v; }
        Bl[tid] = biasd[(kvh * 4 + (tid >> 7)) * 128 + (tid & 127)];
        __syncthreads();
        const bf16_t* qbase = zb + (size_t)(b * SEQ + s0 + 16 * w + ql) * ZW + 2048 + kvh * 256 + q4 * 8;
        bf16x8 Qn0 = *(const bf16x8*)(qbase), Qn1 = *(const bf16x8*)(qbase + 32);
        for (int g = 0; g < 4; ++g) { const int h = kvh * 4 + g;
            const bf16x8 Q0 = Qn0, Q1 = Qn1;
            if (g < 3) { Qn0 = *(const bf16x8*)(qbase + (g + 1) * 64); Qn1 = *(const bf16x8*)(qbase + (g + 1) * 64 + 32); }
            const float sink = P.sinks[layer * 8 + h];
            f32x4 sc[10]; float mx = sink;
#pragma unroll
            for (int tt = 0; tt < 10; ++tt) { const int tl = w + tt, tc = tl < 15 ? tl : 15;
                const bf16x8 K0 = *(const bf16x8*)(Kl + (16 * tc + ql) * 72 + q4 * 8), K1 = *(const bf16x8*)(Kl + (16 * tc + ql) * 72 + 32 + q4 * 8);
                f32x4 a = {0.f, 0.f, 0.f, 0.f}; a = __builtin_amdgcn_mfma_f32_16x16x32_bf16(K0, Q0, a, 0, 0, 0); a = __builtin_amdgcn_mfma_f32_16x16x32_bf16(K1, Q1, a, 0, 0, 0);
#pragma unroll
                for (int j = 0; j < 4; ++j) { const int dist = ql + 128 - 16 * tt - 4 * q4 - j, kj = 16 * tl + 4 * q4 + j;
                    const bool valid = (dist >= 0) && (dist < 128) && (tl < 16) && (blk > 0 || kj >= 128);
                    const float sv = valid ? (a[j] * 0.125f + Bl[g * 128 + (dist & 127)]) : -INFINITY; a[j] = sv; mx = fmaxf(mx, sv); }
                sc[tt] = a; }
            mx = fmaxf(mx, __shfl_xor(mx, 16)); mx = fmaxf(mx, __shfl_xor(mx, 32));
            float l = 0.f;
#pragma unroll
            for (int tt = 0; tt < 10; ++tt)
#pragma unroll
                for (int j = 0; j < 4; ++j) { const float pv = __expf(sc[tt][j] - mx); sc[tt][j] = pv; l += pv; }
            l += __shfl_xor(l, 16); l += __shfl_xor(l, 32); l += __expf(sink - mx);
            const float linv = 1.0f / l;
            f32x4 o[4];
#pragma unroll
            for (int dt = 0; dt < 4; ++dt) o[dt] = (f32x4){0.f, 0.f, 0.f, 0.f};
#pragma unroll
            for (int pp = 0; pp < 5; ++pp) { const int tA = w + 2 * pp, tB = tA + 1, cA_ = tA < 15 ? tA : 15, cB_ = tB < 15 ? tB : 15;
                u32x4 pw; pw.x = cvt_pk_bf16(sc[2 * pp][0], sc[2 * pp][1]); pw.y = cvt_pk_bf16(sc[2 * pp][2], sc[2 * pp][3]); pw.z = cvt_pk_bf16(sc[2 * pp + 1][0], sc[2 * pp + 1][1]); pw.w = cvt_pk_bf16(sc[2 * pp + 1][2], sc[2 * pp + 1][3]);
                bf16x8 Pf; __builtin_memcpy(&Pf, &pw, 16);
#pragma unroll
                for (int dt = 0; dt < 4; ++dt) { const bf16_t* vr = Vl + (16 * dt + ql) * 264 + 4 * q4; const u32x2 va = *(const u32x2*)(vr + 16 * cA_), vb = *(const u32x2*)(vr + 16 * cB_);
                    u32x4 vw; vw.x = va.x; vw.y = va.y; vw.z = vb.x; vw.w = vb.y; bf16x8 Vf; __builtin_memcpy(&Vf, &vw, 16);
                    o[dt] = __builtin_amdgcn_mfma_f32_16x16x32_bf16(Pf, Vf, o[dt], 0, 0, 0); } }
#pragma unroll
            for (int j = 0; j < 4; ++j) { const float li = __shfl(linv, 4 * q4 + j); bf16_t* op = zb + ((size_t)(b * SEQ + s0 + 16 * w + 4 * q4 + j)) * ZW + 2048 + h * 64 + ql;
#pragma unroll
                for (int dt = 0; dt < 4; ++dt) op[16 * dt] = (bf16_t)(cvt_pk_bf16(o[dt][j] * li, 0.f) & 0xffff); }
        }
    }
}

__device__ __forceinline__ void x_init(const Params& P) {
    const int tidx = ltid();
    const int lane = tidx & 63, gw = blockIdx.x * 8 + (tidx >> 6), nw = gridDim.x * 8;
    bf16_t* xb0 = (bf16_t*)(P.ws + OFF_XB0); float* ssq0 = (float*)(P.ws + OFF_SSQ);
    for (int row = gw; row < T_TOK; row += nw) { float ss = 0.f;
#pragma unroll
        for (int k = 0; k < 4; ++k) { const size_t o = (size_t)row * 1024 + k * 256 + lane * 4; const f32x4 v = *(const f32x4*)(P.x + o);
            u32x2 w; w.x = cvt_pk_bf16(v[0], v[1]); w.y = cvt_pk_bf16(v[2], v[3]); *(u32x2*)(xb0 + o) = w; ss += (v[0] * v[0] + v[1] * v[1]) + (v[2] * v[2] + v[3] * v[3]); }
#pragma unroll
        for (int o = 32; o >= 1; o >>= 1) ss += __shfl_xor(ss, o);
        if (lane < 16) ssq0[((size_t)(lane >> 2) * T_TOK + row) * 4 + (lane & 3)] = lane == 0 ? ss : 0.f; }
}
__device__ __forceinline__ void bias_table(const Params& P) {
    const int tidx = ltid();
    if (blockIdx.x == 0) for (int i = tidx; i < 1024; i += 512) { const int h = i >> 7, dist = i & 127; int bucket;
        if (dist < 16) bucket = dist; else { bucket = 16 + (int)(logf((float)dist / 16.0f) / 2.0794415416798357f * 16.0f); bucket = bucket < 31 ? bucket : 31; }
        ((float*)(P.ws + OFF_BIAS))[i] = P.rel_bias[bucket * 8 + h]; }
}
__device__ __forceinline__ void final_norm(const Params& P) {
    const int tidx = ltid();
    const float* ssq0 = (const float*)(P.ws + OFF_SSQ); const bf16_t* xb0 = (const bf16_t*)(P.ws + OFF_XB0);
    const int lane = tidx & 63, gw = blockIdx.x * 8 + (tidx >> 6), nw = gridDim.x * 8;
    f32x4 g[4];
#pragma unroll
    for (int k = 0; k < 4; ++k) g[k] = *(const f32x4*)(P.norm_final + k * 256 + lane * 4);
    for (int row = gw; row < T_TOK; row += nw) {
        float t = 0.f; if (lane < 16) t = __uint_as_float(__hip_atomic_load((unsigned*)(ssq0 + ((size_t)(lane >> 2) * T_TOK + row) * 4 + (lane & 3)), __ATOMIC_RELAXED, __HIP_MEMORY_SCOPE_AGENT));
#pragma unroll
        for (int o = 8; o >= 1; o >>= 1) t += __shfl_xor(t, o);
        const float rs = rsqrtf(__shfl(t, 0) * (1.0f / 1024.0f) + 1e-6f);
#pragma unroll
        for (int k = 0; k < 4; ++k) { const size_t o = (size_t)row * 1024 + k * 256 + lane * 4; const u32x2 w = *(const u32x2*)(xb0 + o);
            f32x4 v; v[0] = bf_lo(w.x); v[1] = bf_hi(w.x); v[2] = bf_lo(w.y); v[3] = bf_hi(w.y); *(f32x4*)(P.out + o) = v * rs * g[k]; }
    }
}


#define XB_TMO      128
#define XB_XCNT(j)  (256  + 64 * (j))
#define XB_XSUB(j)  (1280 + 64 * (j))
#define XB_XGEN(j)  (2304 + 64 * (j))
#define XB_TOP      3328
#define XB_TOPGEN   3392
#define XCD_BAR_WORDS 3456
#define XB_SPIN_CAP (1u << 20)
__device__ __forceinline__ unsigned xb_ld(unsigned* p)              { return __hip_atomic_load(p, __ATOMIC_RELAXED, __HIP_MEMORY_SCOPE_AGENT); }
__device__ __forceinline__ unsigned xb_add(unsigned* p, unsigned v) { return __hip_atomic_fetch_add(p, v, __ATOMIC_RELAXED, __HIP_MEMORY_SCOPE_AGENT); }
__device__ __forceinline__ unsigned xb_xcc_id() { return (unsigned)__builtin_amdgcn_s_getreg((3 << 11) | 20) & 0xFu; }
#define XB_SPIN(cond, bar) do { unsigned _sp = 0; while (cond) { __builtin_amdgcn_s_sleep(1); \
    if ((++_sp & 255u) == 0u) { if (xb_ld(&(bar)[XB_TMO])) break; if (_sp > XB_SPIN_CAP) { atomicAdd(&(bar)[XB_TMO], 1u); break; } } } } while (0)
struct XcdBarrier { unsigned* bar; unsigned x; volatile LAS unsigned* st; };
__device__ __forceinline__ XcdBarrier xcd_barrier_post(unsigned* bar, volatile LAS unsigned* st) {
    XcdBarrier b; b.bar = bar; b.x = xb_xcc_id(); b.st = st;
    if (threadIdx.x == 0) (void)xb_add(&bar[XB_XCNT(b.x)], 1u);
    return b;
}
__device__ __forceinline__ void xcd_barrier_complete(unsigned* bar, unsigned x, unsigned& nloc, unsigned& nx) {
    const unsigned G = gridDim.x * gridDim.y * gridDim.z;
    unsigned sum, cnt, mine, sp = 0u;
    for (;;) {
        sum = 0u; cnt = 0u; mine = 0u;
#pragma unroll
        for (unsigned j = 0; j < 16; ++j) { const unsigned c = xb_ld(&bar[XB_XCNT(j)]); sum += c; cnt += (c > 0u) ? 1u : 0u; mine = (j == x) ? c : mine; }
        if (sum == G) break;
        __builtin_amdgcn_s_sleep(1);
        if ((++sp & 255u) == 0u) { if (xb_ld(&bar[XB_TMO])) break; if (sp > XB_SPIN_CAP) { atomicAdd(&bar[XB_TMO], 1u); break; } }
    }
    nloc = mine > 0u ? mine : 1u; nx = cnt > 0u ? cnt : 1u;
}
__device__ __forceinline__ void xcd_barrier(const XcdBarrier& b) {
    asm volatile("s_waitcnt vmcnt(0)" ::: "memory");
    __syncthreads();
    if (threadIdx.x == 0) {
        unsigned* bar = b.bar;
        __builtin_amdgcn_s_waitcnt(0);
        unsigned nloc = b.st[0], nx = b.st[1];
        if (nloc == 0u) { xcd_barrier_complete(bar, b.x, nloc, nx); b.st[0] = nloc; b.st[1] = nx; }
        const unsigned old = xb_add(&bar[XB_XSUB(b.x)], 1u);
        const unsigned gen = old / nloc;
        if (old + 1u == (gen + 1u) * nloc) {
            __builtin_amdgcn_fence(__ATOMIC_RELEASE, "agent");
            asm volatile("s_waitcnt vmcnt(0)" ::: "memory");
            const unsigned og = xb_add(&bar[XB_TOP], 1u);
            const unsigned tg = og / nx;
            if (og + 1u == (tg + 1u) * nx) xb_add(&bar[XB_TOPGEN], 1u);
            else XB_SPIN(xb_ld(&bar[XB_TOPGEN]) == tg, bar);
            __builtin_amdgcn_fence(__ATOMIC_ACQUIRE, "agent");
            xb_add(&bar[XB_XGEN(b.x)], 1u);
            asm volatile("s_waitcnt vmcnt(0)" ::: "memory");
        } else {
            XB_SPIN(xb_ld(&bar[XB_XGEN(b.x)]) == gen, bar);
            __builtin_amdgcn_fence(__ATOMIC_ACQUIRE, "agent");
            asm volatile("s_waitcnt vmcnt(0)" ::: "memory");
        }
    }
    __syncthreads();
}

typedef const Params __attribute__((address_space(4)))* CParams;
#define LOADP(Pl) Params Pl; { CParams q_ = pk; asm volatile("" : "+s"(q_)); Pl = *q_; }
#define MAKE_E(E, Pl) Epi E; E.ws = Pl.ws; E.x = Pl.out; E.dskip = Pl.ssm_d + layer * 512; E.layer = layer; E.rstab = (const LAS float*)(lds + STAGE_BYTES + 16);
__global__ void __launch_bounds__(512) fwd_megakernel(Params Parg) {
#if defined(__HIP_DEVICE_COMPILE__)
    cg::grid_group grid = cg::this_grid();
    extern __shared__ __attribute__((aligned(16))) unsigned char smem[];
    LAS unsigned char* lds = (LAS unsigned char*)smem;
    CParams pk = (CParams)__builtin_amdgcn_kernarg_segment_ptr();
    volatile LAS unsigned* xst = (volatile LAS unsigned*)(lds + STAGE_BYTES);
    if (threadIdx.x == 0) { xst[0] = 0u; xst[1] = 0u; }
    __syncthreads();
    XcdBarrier xb; { LOADP(P) xb = xcd_barrier_post((unsigned*)(P.ws + OFF_BAR), xst); }
    { LOADP(P) x_init(P); bias_table(P); }
    { LOADP(P) ssm_ktable(smem, P); }
    { LOADP(P) ssm_group_tables_all(P); }
    __syncthreads();
    { LOADP(P) convert_layer(smem, P, 0, 0); }
    if (pk->ws == nullptr) grid.sync();
    xcd_barrier(xb);
    for (int layer = 0; layer < N_LAYERS; ++layer) {
        { LOADP(P) MAKE_E(E, P) gemm_phase<PH_WIN>(lds, E); }
        if (gridDim.x == 256) { if (blockIdx.x >= 128) { LOADP(P) ssm_tables(smem, P, layer, (blockIdx.x - 128) * 2, (blockIdx.x - 128) * 2 + 2, 1); } }
        else { LOADP(P) ssm_tables(smem, P, layer, blockIdx.x, 256, gridDim.x); }
        xcd_barrier(xb);
        { LOADP(P) MAKE_E(E, P) gemm_phase<PH_SSM1>(lds, E); }
        { LOADP(P) attn_phase(smem, P, layer); }
        { LOADP(P) conv_phase(P, layer); }
        xcd_barrier(xb);
        { LOADP(P) ssm_scan(P); }
        if (layer + 1 < N_LAYERS) { LOADP(P) convert_layer(smem, P, layer + 1, 16); }
        xcd_barrier(xb);
        { LOADP(P) MAKE_E(E, P) gemm_phase<PH_SSM2>(lds, E); }
        xcd_barrier(xb);
        { LOADP(P) MAKE_E(E, P) gemm_phase<PH_GLU>(lds, E); }
        xcd_barrier(xb);
        { LOADP(P) MAKE_E(E, P) gemm_phase<PH_MERGE, 0>(lds, E); }
        { LOADP(P) MAKE_E(E, P) gemm_phase<PH_MERGE, 1>(lds, E); }
        xcd_barrier(xb);
        { LOADP(P) MAKE_E(E, P) gemm_phase<PH_WOUT>(lds, E); }
        xcd_barrier(xb);
        { LOADP(P) MAKE_E(E, P) gemm_phase<PH_FFI>(lds, E); }
        xcd_barrier(xb);
        { LOADP(P) MAKE_E(E, P) gemm_phase<PH_FFO>(lds, E); }
        xcd_barrier(xb);
        { LOADP(P) MAKE_E(E, P) gemm_phase<PH_PLE, 0>(lds, E); }
        { LOADP(P) MAKE_E(E, P) gemm_phase<PH_PLE, 1>(lds, E); }
        xcd_barrier(xb);
    }
    { LOADP(P) final_norm(P); }
#endif
}

extern "C" void kernel_launch(void* const* d_in, const int* in_sizes, int n_in, void* d_out, int out_size, void* d_ws, size_t ws_size, hipStream_t stream) {
    constexpr size_t kDynLds = STAGE_BYTES + 16 + 12 * 1024;
    static int grid_blocks = 0;
    if (!grid_blocks) {
        int dev = 0, cus = 0, per_cu = 0;
        hipGetDevice(&dev);
        hipDeviceGetAttribute(&cus, hipDeviceAttributeMultiprocessorCount, dev);
        hipFuncSetAttribute((const void*)fwd_megakernel, hipFuncAttributeMaxDynamicSharedMemorySize, (int)kDynLds);
        hipOccupancyMaxActiveBlocksPerMultiprocessor(&per_cu, fwd_megakernel, 512, kDynLds);
        if (per_cu < 1) per_cu = 1;
        grid_blocks = cus * 1;
    }
    Params P{};
    const float** f = (const float**)&P;
    for (int i = 0; i < 25; ++i) f[i] = (const float*)d_in[i];
    P.out = (float*)d_out; P.ws = (unsigned char*)d_ws;
    (void)hipMemsetAsync((char*)d_ws + OFF_BAR, 0, XCD_BAR_WORDS * sizeof(unsigned), stream);
    void* args[] = {&P};
    hipError_t e = hipLaunchCooperativeKernel((void*)fwd_megakernel, dim3(grid_blocks), dim3(512), args, kDynLds, stream);
    if (e != hipSuccess) fprintf(stderr, "cooperative launch failed: %s (grid %d)\n", hipGetErrorString(e), grid_blocks);
}
```

```cpp
#include <hip/hip_runtime.h>
#include <hip/hip_cooperative_groups.h>
#include <cstdio>
namespace cg = cooperative_groups;

#define LAS __attribute__((address_space(3)))
typedef unsigned short bf16_t;
typedef short bf16x8 __attribute__((ext_vector_type(8)));
typedef float f32x4 __attribute__((ext_vector_type(4)));
typedef unsigned u32x4 __attribute__((ext_vector_type(4)));
typedef unsigned u32x2 __attribute__((ext_vector_type(2)));

#ifndef N_LAYERS
#define N_LAYERS 4
#endif

constexpr int T_TOK = 32768, SEQ = 8192, DM = 1024, ZW = 2816, INW = 5888, FFH = 2816;
constexpr int LCH = 32;
constexpr size_t MiB = 1048576;
constexpr size_t OFF_WB = 0, WB_BYTES = 36 * MiB, OFF_PB = 72 * MiB, PB_BYTES = 16 * MiB, OFF_XB0 = 104 * MiB, OFF_SSQ = 168 * MiB, SSQ_BYTES = 2 * MiB,
                 OFF_ZB = 174 * MiB, OFF_YI = 350 * MiB, OFF_MG = 382 * MiB, OFF_TG = 446 * MiB, OFF_MO = 470 * MiB, OFF_S = 478 * MiB, OFF_H = 494 * MiB,
                 OFF_VT = 510 * MiB, OFF_KT = 518 * MiB, OFF_AL = 522 * MiB, OFF_BIAS = 522 * MiB + 65536, OFF_GT = 523 * MiB, OFF_BAR = 528 * MiB;
constexpr size_t W_IN = 0, W_G = 2883584, W_GLU = 6029312, W_BR = 6291456, W_OUT = 7864320, W_FFI = 8912896, W_FFO = 14680064, W_PG = 17563648, W_PP = 18612224;

struct Params {
    const float *x, *p, *rel_bias, *norm_mix, *w_in, *lam_re, *lam_im, *b_re, *b_im, *c_re, *c_im, *ssm_d, *log_dt, *w_glu, *conv_w, *sinks, *w_branch, *w_out,
        *norm_ffn, *w_ffn_in, *w_ffn_out, *norm_ple, *w_ple_gate, *w_ple_proj, *norm_final;
    float* out; unsigned char* ws;
};

__device__ __forceinline__ int ltid() { int t = threadIdx.x; asm volatile("" : "+v"(t)); return t; }
__device__ __forceinline__ unsigned cvt_pk_bf16(float lo, float hi) { unsigned r; asm volatile("v_cvt_pk_bf16_f32 %0, %1, %2" : "=v"(r) : "v"(lo), "v"(hi)); return r; }
__device__ __forceinline__ float bf_lo(unsigned w) { return __uint_as_float(w << 16); }
__device__ __forceinline__ float bf_hi(unsigned w) { return __uint_as_float(w & 0xffff0000u); }
__device__ __forceinline__ float sigmoidf_(float v) { return __builtin_amdgcn_rcpf(1.0f + __expf(-v)); }
__device__ __forceinline__ float gelu_tanh(float y) { const float z = 1.5957691216057308f * (y + 0.044715f * y * y * y); return y * sigmoidf_(z); }
__device__ __forceinline__ u32x4 pack8(const f32x4 a, const f32x4 b) { u32x4 w; w.x = cvt_pk_bf16(a[0], a[1]); w.y = cvt_pk_bf16(a[2], a[3]); w.z = cvt_pk_bf16(b[0], b[1]); w.w = cvt_pk_bf16(b[2], b[3]); return w; }
__device__ __forceinline__ void unpack8(const u32x4 w, f32x4& a, f32x4& b) { a[0] = bf_lo(w.x); a[1] = bf_hi(w.x); a[2] = bf_lo(w.y); a[3] = bf_hi(w.y); b[0] = bf_lo(w.z); b[1] = bf_hi(w.z); b[2] = bf_lo(w.w); b[3] = bf_hi(w.w); }
__device__ __forceinline__ unsigned pack4_u8(const f32x4 v) { const unsigned q0 = (unsigned)(v[0] * 255.0f + 0.5f), q1 = (unsigned)(v[1] * 255.0f + 0.5f), q2 = (unsigned)(v[2] * 255.0f + 0.5f), q3 = (unsigned)(v[3] * 255.0f + 0.5f);
    return q0 | (q1 << 8) | (q2 << 16) | (q3 << 24); }
__device__ __forceinline__ unsigned pack4_u8c(const f32x4 v) { const unsigned q0 = (unsigned)fmaxf(v[0] * 255.0f + 0.5f, 1.0f), q1 = (unsigned)fmaxf(v[1] * 255.0f + 0.5f, 1.0f), q2 = (unsigned)fmaxf(v[2] * 255.0f + 0.5f, 1.0f), q3 = (unsigned)fmaxf(v[3] * 255.0f + 0.5f, 1.0f);
    return q0 | (q1 << 8) | (q2 << 16) | (q3 << 24); }
__device__ __forceinline__ f32x4 unpack4_raw(const unsigned w) { f32x4 v; v[0] = (float)(w & 0xffu); v[1] = (float)((w >> 8) & 0xffu); v[2] = (float)((w >> 16) & 0xffu); v[3] = (float)(w >> 24); return v; }
__device__ __forceinline__ f32x4 unpack4_u8(const unsigned w) { f32x4 v; v[0] = (float)(w & 0xffu); v[1] = (float)((w >> 8) & 0xffu); v[2] = (float)((w >> 16) & 0xffu); v[3] = (float)(w >> 24); return v * (1.0f / 255.0f); }
__device__ __forceinline__ unsigned pack4_fp8(float a, float b, float c, float d) { unsigned w = 0u; w = __builtin_amdgcn_cvt_pk_fp8_f32(a, b, w, false); w = __builtin_amdgcn_cvt_pk_fp8_f32(c, d, w, true); return w; }
typedef long i64x2 __attribute__((ext_vector_type(2)));
__device__ __forceinline__ f32x4 mma_fp8(const bf16x8 b, const bf16x8 a, f32x4 c) { i64x2 bb, aa; __builtin_memcpy(&bb, &b, 16); __builtin_memcpy(&aa, &a, 16);
    c = __builtin_amdgcn_mfma_f32_16x16x32_fp8_fp8(bb.x, aa.x, c, 0, 0, 0); c = __builtin_amdgcn_mfma_f32_16x16x32_fp8_fp8(bb.y, aa.y, c, 0, 0, 0); return c; }
constexpr float GATE_WSCALE = 64.0f;
__device__ __forceinline__ float row_rs(const float* ssq, int row) {
    float s = 0.f;
#pragma unroll
    for (int pn = 0; pn < 4; ++pn)
#pragma unroll
        for (int j = 0; j < 4; ++j) s += __uint_as_float(__hip_atomic_load((unsigned*)(ssq + ((size_t)pn * T_TOK + row) * 4 + j), __ATOMIC_RELAXED, __HIP_MEMORY_SCOPE_AGENT));
    return rsqrtf(s * (1.0f / 1024.0f) + 1e-6f);
}

constexpr int BM = 256, BK = 64, HALF = 128, HTB = HALF * BK * 2, STAGE_BYTES = 8 * HTB;
__device__ __forceinline__ int lds_byte(int r, int c) { const int st = (r >> 4) * 2 + (c >> 5), rr = r & 15, cc = c & 31, ob = rr * 64 + cc * 2; return st * 1024 + (ob ^ (((ob >> 9) & 1) << 5)); }
__device__ __forceinline__ void stage_rc(int b, int& R, int& C) { const int st = b / 1024, sb = b % 1024, swz = sb ^ (((sb >> 9) & 1) << 5); R = (st >> 1) * 16 + swz / 64; C = (st & 1) * 32 + (swz % 64) / 2; }
__device__ __forceinline__ int perm32(int rho) { const int n = rho >> 4, i = rho & 15; return 8 * (i >> 2) + 4 * n + (i & 3); }

enum { K_WIN = 0, K_SSM1, K_SSM2, K_GLU, K_MG_G, K_MG_B, K_XADD, K_FFI, K_PP, K_PLE };
enum { PH_WIN = 0, PH_SSM1, PH_SSM2, PH_GLU, PH_MERGE, PH_WOUT, PH_FFI, PH_FFO, PH_PLE };

struct Unit {
    const char* A; const char* B;
    int pm, pn, aux, ord;
};
struct Shape { unsigned rsA, ssA, Kb; int nt, kind; };
template <int PH, int SUB> __device__ __forceinline__ constexpr Shape shape_of() {
    switch (PH) {
    case PH_WIN: return Shape{2048u, 32u, 1024u, 16, K_WIN};
    case PH_SSM1: return Shape{(unsigned)(LCH * 32), 32u, 512u, 8, K_SSM1};
    case PH_SSM2: return Shape{32u * 256u * 2u, 32u, 256u, 4, K_SSM2};
    case PH_GLU: return Shape{32u, (unsigned)(T_TOK * 32), 512u, 8, K_GLU};
    case PH_MERGE: return (SUB & 1) == 0 ? Shape{(unsigned)(ZW * 2), 32u, 512u, 8, K_MG_G} : Shape{(unsigned)(ZW * 2), 32u, 512u, 8, K_MG_B};
    case PH_WOUT: return Shape{2048u, 32u, 1024u, 16, K_XADD};
    case PH_FFI: return Shape{2048u, 32u, 1024u, 16, K_FFI};
    case PH_FFO: return Shape{(unsigned)(ZW * 2), 32u, (unsigned)FFH, 44, K_XADD};
    default: return SUB == 0 ? Shape{512u, 32u, 256u, 4, K_PP} : Shape{2048u, 32u, 1024u, 16, K_PLE};
    }
}

__device__ __forceinline__ void tile_map(int wgid, int nM, int nN, int& pm, int& pn) {
    const int nwg = nM * nN; { const int q = nwg / 8, r = nwg % 8, xcd = wgid % 8, off = wgid / 8; wgid = (xcd < r ? xcd * (q + 1) : r * (q + 1) + (xcd - r) * q) + off; }
    const int nig = 8 * nN, gid = wgid / nig, fm = gid * 8, gsz = (nM - fm) < 8 ? (nM - fm) : 8;
    pm = fm + ((wgid % nig) % gsz); pn = (wgid % nig) / gsz;
}

template <int PH, int SUB> __device__ __forceinline__ bool sched_next(unsigned char* ws, int layer, int i, Unit& u, const void* ug = nullptr) {
    const int G = gridDim.x, c = blockIdx.x;
    const char* wb = (const char*)ws + OFF_WB + (size_t)(layer & 1) * WB_BYTES;
    const char* xb0 = (const char*)ws + OFF_XB0; const char* zb = (const char*)ws + OFF_ZB; const char* mg = (const char*)ws + OFF_MG;
    u.aux = 0; u.ord = i;
    if constexpr (PH == PH_WIN) { const int L = i * G + c; if (L >= 128 * 11) return false; tile_map(L, 128, 11, u.pm, u.pn);
        u.A = xb0 + (size_t)u.pm * 256 * 2048; u.B = wb + W_IN * 2 + (size_t)u.pn * 256 * 2048; return true; }
    if constexpr (PH == PH_SSM1) { const int L = i * G + c; if (L >= 384) return false; const int g = L / 12, rem = L % 12; u.pm = rem / 3; u.pn = rem % 3; u.aux = g;
        u.A = (const char*)ug + ((size_t)g * T_TOK + (size_t)u.pm * 256 * LCH) * 32; u.B = (const char*)ws + OFF_TG + ((size_t)g * 768 + u.pn * 256) * 512 * 2; return true; }
    if constexpr (PH == PH_SSM2) { const int L = i * G + c; if (L >= 256) return false; const int g = L / 8; u.pm = (L % 8) / 2; u.pn = L % 2; u.aux = g;
        u.A = (const char*)ws + OFF_H + ((size_t)u.pm * 256 * 32 + g) * 256 * 2; u.B = (const char*)ws + OFF_MO + ((size_t)g * 512 + u.pn * 256) * 256 * 2; return true; }
    if constexpr (PH == PH_GLU) { const int L = i * G + c; if (L >= 256) return false; tile_map(L, 128, 2, u.pm, u.pn);
        u.A = (const char*)ws + OFF_YI + (size_t)u.pm * 256 * 32; u.B = wb + W_GLU * 2 + (size_t)u.pn * 256 * 512 * 2; return true; }
    if constexpr (PH == PH_MERGE) { const int ui = i / 3, r = i % 3, L = ui * G + c; if (L >= 512) return false; tile_map(L, 128, 4, u.pm, u.pn); u.aux = r; u.ord = ui;
        if constexpr ((SUB & 1) == 0) { u.A = zb + (size_t)u.pm * 256 * ZW * 2; u.B = wb + W_G * 2 + ((size_t)r * 1024 + u.pn * 256) * 1024; }
        else { u.A = zb + ((size_t)u.pm * 256 * ZW + (r == 0 ? 1024 : (r == 1 ? 512 : 2048))) * 2; u.B = wb + W_BR * 2 + ((size_t)r * 1024 + u.pn * 256) * 1024; }
        return true; }
    if constexpr (PH == PH_WOUT) { const int L = i * G + c; if (L >= 512) return false; tile_map(L, 128, 4, u.pm, u.pn);
        u.A = mg + (size_t)u.pm * 256 * 2048; u.B = wb + W_OUT * 2 + (size_t)u.pn * 256 * 2048; return true; }
    if constexpr (PH == PH_FFI) { const int L = i * G + c; if (L >= 128 * 22) return false; tile_map(L, 128, 22, u.pm, u.pn);
        u.A = xb0 + (size_t)u.pm * 256 * 2048; u.B = wb + W_FFI * 2 + (size_t)u.pn * 256 * 2048; return true; }
    if constexpr (PH == PH_FFO) { const int L = i * G + c; if (L >= 512) return false; tile_map(L, 128, 4, u.pm, u.pn); u.aux = 1;
        u.A = zb + (size_t)u.pm * 256 * ZW * 2; u.B = wb + W_FFO * 2 + (size_t)u.pn * 256 * FFH * 2; return true; }
    if constexpr (PH == PH_PLE) { const int L = i * G + c; if (L >= 512) return false; tile_map(L, 128, 4, u.pm, u.pn);
        if constexpr (SUB == 0) { u.A = (const char*)ws + OFF_PB + (size_t)(layer & 1) * PB_BYTES + (size_t)u.pm * 256 * 512; u.B = wb + W_PP * 2 + (size_t)u.pn * 256 * 512; }
        else { u.A = mg + (size_t)u.pm * 256 * 2048; u.B = wb + W_PG * 2 + (size_t)u.pn * 256 * 2048; }
        return true; }
    return false;
}

#define MEMFENCE asm volatile("" ::: "memory")
struct Epi {
    unsigned char* ws; float* x; const float* dskip; int layer; const LAS float* rstab;
    __device__ __forceinline__ void load_rs(const float* ssq, int rbase, int fq, float (&rs)[8]) const {
        f32x4 q[8];
#pragma unroll
        for (int r8 = 0; r8 < 8; ++r8) q[r8] = *(const f32x4*)(ssq + (size_t)(rbase + (r8 >> 2) * 128 + (r8 & 3) * 16) * 16 + fq * 4);
#pragma unroll
        for (int r8 = 0; r8 < 8; ++r8) { float t = (q[r8][0] + q[r8][1]) + (q[r8][2] + q[r8][3]); t += __shfl_xor(t, 16); t += __shfl_xor(t, 32); rs[r8] = rsqrtf(t * (1.0f / 1024.0f) + 1e-6f); }
    }
    __device__ __forceinline__ void get_rs(const Unit& u, int wr, int fr, float (&rs)[8]) const {
#pragma unroll
        for (int r8 = 0; r8 < 8; ++r8) rs[r8] = rstab[u.ord * 256 + (r8 >> 2) * 128 + wr * 64 + (r8 & 3) * 16 + fr];
    }
    template <int KIND> __device__ __forceinline__ void run(f32x4 (&acc)[2][2][4][2], const Unit& u, int tid_in) const {
        int tid = tid_in; asm volatile("" : "+v"(tid));
        const int wid = __builtin_amdgcn_readfirstlane(tid >> 6), lane = tid & 63, wr = wid >> 2, wc = wid & 3, fr = lane & 15, fq = lane >> 4;
        bf16_t* zb = (bf16_t*)(ws + OFF_ZB); bf16_t* yi = (bf16_t*)(ws + OFF_YI); bf16_t* mg = (bf16_t*)(ws + OFF_MG); bf16_t* xb0 = (bf16_t*)(ws + OFF_XB0);
        float* ssq0 = (float*)(ws + OFF_SSQ); float* ssq1 = (float*)(ws + OFF_SSQ + SSQ_BYTES); float* ssq2 = (float*)(ws + OFF_SSQ + 2 * SSQ_BYTES);
        u32x4* scr = (u32x4*)(ws + OFF_TG + ((size_t)blockIdx.x * 2 + (u.ord & 1)) * 131072);
        const int rbase = u.pm * 256 + wr * 64 + fr, cl = wc * 32 + fq * 8;
        if constexpr (KIND == K_WIN) { float rs[8]; get_rs(u, wr, fr, rs);
#pragma unroll
            for (int ai = 0; ai < 2; ++ai)
#pragma unroll
                for (int m = 0; m < 4; ++m) { int row = rbase + ai * 128 + m * 16; asm volatile("" : "+v"(row)); const float r = rs[ai * 4 + m];
                    if (u.pn >= 4 && u.pn < 8) {
                        const f32x4 v0 = (acc[ai][0][m][0] * r) * (acc[ai][1][m][0] * r), v1 = (acc[ai][0][m][1] * r) * (acc[ai][1][m][1] * r);
                        *(u32x4*)(zb + (size_t)row * ZW + 1024 + (u.pn - 4) * 128 + cl) = pack8(v0, v1); }
                    else
#pragma unroll
                    for (int bj = 0; bj < 2; ++bj) { const u32x4 w = pack8(acc[ai][bj][m][0] * r, acc[ai][bj][m][1] * r);
                        if (u.pn < 2) { const int col = u.pn * 256 + bj * 128 + cl; *(u32x4*)((bf16_t*)x + ((size_t)(col >> 4) * T_TOK + row) * 16 + (col & 15)) = w; }
                        else if (u.pn < 10 || bj == 0) *(u32x4*)(zb + (size_t)row * ZW + u.pn * 256 + bj * 128 + cl) = w;
                        else { const int b = row >> 13, s = row & 8191; bf16_t* vp = (bf16_t*)(ws + OFF_VT) + ((size_t)(b * 128 + cl)) * SEQ + s;
                            vp[0 * SEQ] = (bf16_t)(w.x & 0xffff); vp[1 * SEQ] = (bf16_t)(w.x >> 16); vp[2 * SEQ] = (bf16_t)(w.y & 0xffff); vp[3 * SEQ] = (bf16_t)(w.y >> 16);
                            vp[4 * SEQ] = (bf16_t)(w.z & 0xffff); vp[5 * SEQ] = (bf16_t)(w.z >> 16); vp[6 * SEQ] = (bf16_t)(w.w & 0xffff); vp[7 * SEQ] = (bf16_t)(w.w >> 16); } } MEMFENCE; }
        }
        if constexpr (KIND == K_SSM1) { const int g = u.aux;
#pragma unroll
            for (int ai = 0; ai < 2; ++ai)
#pragma unroll
                for (int m = 0; m < 4; ++m) { int R = rbase + ai * 128 + m * 16; asm volatile("" : "+v"(R));
                    if (u.pn < 2) {
#pragma unroll
                        for (int bj = 0; bj < 2; ++bj) { const int t = 16 * u.pn + 8 * bj + 2 * wc + (fq >> 1), p0 = 8 * (fq & 1);
                            *(u32x4*)(yi + ((size_t)g * T_TOK + (size_t)(R * LCH + t)) * 16 + p0) = pack8(acc[ai][bj][m][0], acc[ai][bj][m][1]); }
                    } else { float* sp = (float*)(ws + OFF_S) + ((size_t)(R * 32 + g)) * 128 + cl; *(f32x4*)sp = acc[ai][0][m][0]; *(f32x4*)(sp + 4) = acc[ai][0][m][1]; } }
        }
        if constexpr (KIND == K_SSM2) { const int g = u.aux; const int ch = g * 16 + 8 * (fq & 1); const f32x4 d0 = *(const f32x4*)(dskip + ch), d1 = *(const f32x4*)(dskip + ch + 4);
#pragma unroll
            for (int ai = 0; ai < 2; ++ai)
#pragma unroll
                for (int mh = 0; mh < 2; ++mh) { u32x4 yv[2][2], uv[2][2];
#pragma unroll
                    for (int ml = 0; ml < 2; ++ml) { int R = rbase + ai * 128 + (mh * 2 + ml) * 16; asm volatile("" : "+v"(R));
#pragma unroll
                        for (int bj = 0; bj < 2; ++bj) { const int t = 16 * u.pn + 8 * bj + 2 * wc + (fq >> 1); const size_t tok = (size_t)R * LCH + t;
                            yv[ml][bj] = *(const u32x4*)(yi + ((size_t)g * T_TOK + tok) * 16 + 8 * (fq & 1)); uv[ml][bj] = *(const u32x4*)((const bf16_t*)x + ((size_t)g * T_TOK + tok) * 16 + 8 * (fq & 1)); } }
#pragma unroll
                    for (int ml = 0; ml < 2; ++ml) { const int m = mh * 2 + ml; int R = rbase + ai * 128 + m * 16; asm volatile("" : "+v"(R));
#pragma unroll
                        for (int bj = 0; bj < 2; ++bj) { const int t = 16 * u.pn + 8 * bj + 2 * wc + (fq >> 1); const size_t tok = (size_t)R * LCH + t;
                            f32x4 y0, y1, u0, u1; unpack8(yv[ml][bj], y0, y1); unpack8(uv[ml][bj], u0, u1);
                            y0 = acc[ai][bj][m][0] + y0 + d0 * u0; y1 = acc[ai][bj][m][1] + y1 + d1 * u1;
#pragma unroll
                            for (int j = 0; j < 4; ++j) { y0[j] = gelu_tanh(y0[j]); y1[j] = gelu_tanh(y1[j]); }
                            *(u32x4*)(yi + ((size_t)g * T_TOK + tok) * 16 + 8 * (fq & 1)) = pack8(y0, y1); } }
                    MEMFENCE; }
        }
        if constexpr (KIND == K_GLU) {
#pragma unroll
            for (int ai = 0; ai < 2; ++ai) { u32x4 yv[4][2];
#pragma unroll
                for (int m = 0; m < 4; ++m) { int row = rbase + ai * 128 + m * 16; asm volatile("" : "+v"(row));
#pragma unroll
                    for (int bj = 0; bj < 2; ++bj) { const int col = u.pn * 256 + bj * 128 + cl; yv[m][bj] = *(const u32x4*)(yi + ((size_t)(col >> 4) * T_TOK + row) * 16 + (col & 15)); } }
#pragma unroll
                for (int m = 0; m < 4; ++m) { int row = rbase + ai * 128 + m * 16; asm volatile("" : "+v"(row));
#pragma unroll
                    for (int bj = 0; bj < 2; ++bj) { const int col = u.pn * 256 + bj * 128 + cl; f32x4 y0, y1; unpack8(yv[m][bj], y0, y1);
#pragma unroll
                        for (int j = 0; j < 4; ++j) { y0[j] *= sigmoidf_(acc[ai][bj][m][0][j]); y1[j] *= sigmoidf_(acc[ai][bj][m][1][j]); }
                        *(u32x4*)(zb + (size_t)row * ZW + 1024 + col) = pack8(y0, y1); } }
                MEMFENCE; }
        }
        if constexpr (KIND == K_MG_G) { float rs[8]; get_rs(u, wr, fr, rs);
            u32x4* gst = (u32x4*)((unsigned char*)x + 32 * MiB) + ((size_t)(blockIdx.x * 2 + (u.ord & 1)) * 3 + u.aux) * 4096;
#pragma unroll
            for (int ai = 0; ai < 2; ++ai)
#pragma unroll
                for (int m = 0; m < 4; ++m) { const float r = rs[ai * 4 + m] * (1.0f / GATE_WSCALE); u32x4 w;
#pragma unroll
                    for (int bj = 0; bj < 2; ++bj) { f32x4 a = acc[ai][bj][m][0] * r, b = acc[ai][bj][m][1] * r;
#pragma unroll
                        for (int j = 0; j < 4; ++j) { a[j] = sigmoidf_(a[j]); b[j] = sigmoidf_(b[j]); }
                        if (bj == 0) { w.x = pack4_u8c(a); w.y = pack4_u8c(b); } else { w.z = pack4_u8c(a); w.w = pack4_u8c(b); } }
                    gst[(ai * 4 + m) * 512 + tid] = w; MEMFENCE; }
        }
        if constexpr (KIND == K_PP) {
#pragma unroll
            for (int ai = 0; ai < 2; ++ai)
#pragma unroll
                for (int m = 0; m < 4; ++m)
#pragma unroll
                    for (int bj = 0; bj < 2; ++bj) { scr[((ai * 4 + m) * 2 + bj) * 512 + tid] = pack8(acc[ai][bj][m][0], acc[ai][bj][m][1]); if (bj == 1) MEMFENCE; }
        }
        if constexpr (KIND == K_MG_B) { const int r = u.aux;
            const u32x4* gst = (const u32x4*)((unsigned char*)x + 32 * MiB) + ((size_t)(blockIdx.x * 2 + (u.ord & 1)) * 3) * 4096;
#pragma unroll
            for (int ai = 0; ai < 2; ++ai)
#pragma unroll
                for (int mh = 0; mh < 2; ++mh) { u32x4 qa[2], qb[2];
#pragma unroll
                    for (int ml = 0; ml < 2; ++ml) { const int m = mh * 2 + ml; qa[ml] = gst[(size_t)r * 4096 + (ai * 4 + m) * 512 + tid]; qb[ml] = (r < 2) ? gst[(size_t)(r + 1) * 4096 + (ai * 4 + m) * 512 + tid] : qa[ml]; }
#pragma unroll
                    for (int ml = 0; ml < 2; ++ml) { const int m = mh * 2 + ml; int row = rbase + ai * 128 + m * 16; asm volatile("" : "+v"(row));
#pragma unroll
                        for (int bj = 0; bj < 2; ++bj) {
                            const f32x4 n0 = unpack4_raw(bj == 0 ? qa[ml].x : qa[ml].z), n1 = unpack4_raw(bj == 0 ? qa[ml].y : qa[ml].w);
                            if (r < 2) { const f32x4 d0 = unpack4_raw(bj == 0 ? qb[ml].x : qb[ml].z), d1 = unpack4_raw(bj == 0 ? qb[ml].y : qb[ml].w);
#pragma unroll
                                for (int j = 0; j < 4; ++j) { acc[ai][bj][m][0][j] *= n0[j] * __builtin_amdgcn_rcpf(d0[j]); acc[ai][bj][m][1][j] *= n1[j] * __builtin_amdgcn_rcpf(d1[j]); } }
                            else { const f32x4 o0 = acc[ai][bj][m][0] * n0 * (1.0f / 255.0f), o1 = acc[ai][bj][m][1] * n1 * (1.0f / 255.0f);
                                *(u32x4*)(mg + (size_t)row * 1024 + u.pn * 256 + bj * 128 + cl) = pack8(o0, o1); } } }
                    MEMFENCE; }
        }
        if constexpr (KIND == K_XADD) {
            const bf16_t* xsrc = xb0; bf16_t* xbo = (u.aux ? mg : xb0); float* sso = (u.aux ? ssq2 : ssq1);
            u32x4 xv[2][2][2];
#define XLOAD(gi, bufi) do { _Pragma("unroll") for (int ml = 0; ml < 2; ++ml) { const int m_ = ((gi) & 1) * 2 + ml; int row_ = rbase + ((gi) >> 1) * 128 + m_ * 16; asm volatile("" : "+v"(row_)); \
                _Pragma("unroll") for (int bj = 0; bj < 2; ++bj) xv[bufi][ml][bj] = *(const u32x4*)(xsrc + (size_t)row_ * 1024 + u.pn * 256 + bj * 128 + cl); } } while (0)
            XLOAD(0, 0);
#pragma unroll
            for (int gi = 0; gi < 4; ++gi) { const int ai = gi >> 1, mh = gi & 1, bufi = gi & 1;
                if (gi < 3) XLOAD(gi + 1, (gi + 1) & 1);
#pragma unroll
                for (int ml = 0; ml < 2; ++ml) { const int m = mh * 2 + ml; int row = rbase + ai * 128 + m * 16; asm volatile("" : "+v"(row)); float ss = 0.f;
#pragma unroll
                    for (int bj = 0; bj < 2; ++bj) { const size_t off = (size_t)row * 1024 + u.pn * 256 + bj * 128 + cl; f32x4 x0, x1; unpack8(xv[bufi][ml][bj], x0, x1);
                        const f32x4 o0 = x0 + acc[ai][bj][m][0], o1 = x1 + acc[ai][bj][m][1];
                        *(u32x4*)(xbo + off) = pack8(o0, o1);
                        ss += (o0[0] * o0[0] + o0[1] * o0[1]) + (o0[2] * o0[2] + o0[3] * o0[3]) + (o1[0] * o1[0] + o1[1] * o1[1]) + (o1[2] * o1[2] + o1[3] * o1[3]); }
                    ss += __shfl_xor(ss, 16); ss += __shfl_xor(ss, 32);
                    if (fq == 0) sso[((size_t)u.pn * T_TOK + row) * 4 + wc] = ss; }
                MEMFENCE; }
#undef XLOAD
        }
        if constexpr (KIND == K_PLE) {
            const bf16_t* xsrc = mg; float rs[8]; get_rs(u, wr, fr, rs);
#pragma unroll
            for (int ai = 0; ai < 2; ++ai)
#pragma unroll
                for (int mh = 0; mh < 2; ++mh) { u32x4 xv[2][2], pv[2][2];
#pragma unroll
                    for (int ml = 0; ml < 2; ++ml) { const int m = mh * 2 + ml; int row = rbase + ai * 128 + m * 16; asm volatile("" : "+v"(row));
#pragma unroll
                        for (int bj = 0; bj < 2; ++bj) { xv[ml][bj] = *(const u32x4*)(xsrc + (size_t)row * 1024 + u.pn * 256 + bj * 128 + cl); pv[ml][bj] = scr[((ai * 4 + m) * 2 + bj) * 512 + tid]; } }
#pragma unroll
                    for (int ml = 0; ml < 2; ++ml) { const int m = mh * 2 + ml; int row = rbase + ai * 128 + m * 16; asm volatile("" : "+v"(row)); float ss = 0.f; const float r = rs[ai * 4 + m];
#pragma unroll
                        for (int bj = 0; bj < 2; ++bj) { const size_t off = (size_t)row * 1024 + u.pn * 256 + bj * 128 + cl; f32x4 a = acc[ai][bj][m][0], b = acc[ai][bj][m][1], p0, p1, x0, x1;
                            unpack8(pv[ml][bj], p0, p1); unpack8(xv[ml][bj], x0, x1);
#pragma unroll
                            for (int j = 0; j < 4; ++j) { a[j] = sigmoidf_(a[j] * r) * p0[j]; b[j] = sigmoidf_(b[j] * r) * p1[j]; }
                            const f32x4 o0 = x0 + a, o1 = x1 + b;
                            *(u32x4*)(xb0 + off) = pack8(o0, o1);
                            { u32x2 w8; w8.x = pack4_fp8(o0[0], o0[1], o0[2], o0[3]); w8.y = pack4_fp8(o1[0], o1[1], o1[2], o1[3]); *(u32x2*)((unsigned char*)zb + (size_t)row * (ZW * 2) + u.pn * 256 + bj * 128 + cl) = w8; }
                            ss += (o0[0] * o0[0] + o0[1] * o0[1]) + (o0[2] * o0[2] + o0[3] * o0[3]) + (o1[0] * o1[0] + o1[1] * o1[1]) + (o1[2] * o1[2] + o1[3] * o1[3]); }
                        ss += __shfl_xor(ss, 16); ss += __shfl_xor(ss, 32);
                        if (fq == 0) ssq0[((size_t)u.pn * T_TOK + row) * 4 + wc] = ss; }
                    MEMFENCE; }
        }
        if constexpr (KIND == K_FFI) { bf16_t* act = zb; float rs[8]; get_rs(u, wr, fr, rs);
#pragma unroll
            for (int ai = 0; ai < 2; ++ai)
#pragma unroll
                for (int m = 0; m < 4; ++m) { int row = rbase + ai * 128 + m * 16; asm volatile("" : "+v"(row)); const float r = rs[ai * 4 + m]; f32x4 o[2];
#pragma unroll
                    for (int n = 0; n < 2; ++n) { const f32x4 g = acc[ai][0][m][n] * r, v = acc[ai][1][m][n] * r;
#pragma unroll
                        for (int j = 0; j < 4; ++j) o[n][j] = g[j] * sigmoidf_(g[j]) * v[j]; }
                    *(u32x4*)(act + (size_t)row * ZW + u.pn * 128 + cl) = pack8(o[0], o[1]); MEMFENCE; }
        }
    }
};


template <int PH, int SUB> __device__ __forceinline__ void rs_fill(LAS unsigned char* lds, const Epi& E) {
    constexpr int kind = shape_of<PH, SUB>().kind;
    if constexpr ((kind == K_WIN || kind == K_MG_G || kind == K_FFI || kind == K_PLE) && !(PH == PH_MERGE && SUB != 0)) {
        const int tidx = ltid();
        const float* ssq = (const float*)(E.ws + OFF_SSQ + (kind == K_FFI ? SSQ_BYTES : (kind == K_PLE ? 2 * SSQ_BYTES : 0)));
        LAS float* tab = (LAS float*)(lds + STAGE_BYTES + 16);
        for (int i = 0; i < 12; ++i) { Unit u; if (!sched_next<PH, SUB>(E.ws, E.layer, i, u)) break;
            const int r = tidx >> 1, hf = tidx & 1; const size_t row = (size_t)(u.pm * 256 + r); f32x4 a, b;
            { unsigned* pa = (unsigned*)(ssq + ((size_t)(2 * hf) * T_TOK + row) * 4); unsigned* pb = (unsigned*)(ssq + ((size_t)(2 * hf + 1) * T_TOK + row) * 4);
#pragma unroll
              for (int j = 0; j < 4; ++j) { a[j] = __uint_as_float(__hip_atomic_load(pa + j, __ATOMIC_RELAXED, __HIP_MEMORY_SCOPE_AGENT)); b[j] = __uint_as_float(__hip_atomic_load(pb + j, __ATOMIC_RELAXED, __HIP_MEMORY_SCOPE_AGENT)); } }
            float t = ((a[0] + a[1]) + (a[2] + a[3])) + ((b[0] + b[1]) + (b[2] + b[3])); t += __shfl_xor(t, 1);
            if (hf == 0) tab[u.ord * 256 + r] = rsqrtf(t * (1.0f / 1024.0f) + 1e-6f); }
        __syncthreads();
    }
}
template <int PH, int SUB = 0> __device__ __forceinline__ void gemm_phase(LAS unsigned char* lds, const Epi& E) {
    rs_fill<PH, SUB>(lds, E);
    int tid = threadIdx.x; asm volatile("" : "+v"(tid));
    const int wid = __builtin_amdgcn_readfirstlane(tid >> 6), lane = tid & 63, wr = wid >> 2, wc = wid & 3, fr = lane & 15, fq = lane >> 4;
    int R0, C0; stage_rc(tid * 16, R0, C0);
    const unsigned Rb0 = (unsigned)((R0 & ~31) + perm32(R0 & 31)), c1 = (unsigned)(C0 >> 4), c0b = (unsigned)((C0 & 15) * 2);
    const unsigned ldsw = (unsigned)wid * 1024u;
    const int aoff = lds_byte(wr * 64 + fr, fq * 8), boff = lds_byte(wc * 32 + fr, fq * 8);
    constexpr Shape cs = shape_of<PH, SUB>(); constexpr bool FP8 = (PH == PH_MERGE && (SUB & 1) == 0);
    const unsigned cA0 = (unsigned)R0 * cs.rsA + c1 * cs.ssA + c0b, cB0 = (Rb0 * cs.Kb + (unsigned)C0) * 2u;
    constexpr size_t chA = (size_t)128 * cs.rsA, ckA = (size_t)4 * cs.ssA, chB = (size_t)256 * cs.Kb, qA = (size_t)64 * cs.rsA, qB = (size_t)128 * cs.Kb, kB = 128;
    constexpr int nt = cs.nt;
#define G_SA(b, h) (((b) * 2 + (h)) * HTB)
#define G_SB(b, h) ((4 + (b) * 2 + (h)) * HTB)
#define G_STAGE(bufoff, gbase, o0, h64) do { \
        __builtin_amdgcn_global_load_lds((const unsigned*)((const char*)(gbase) + (o0)), (LAS unsigned*)(lds + (bufoff) + ldsw), 16, 0, 0); \
        __builtin_amdgcn_global_load_lds((const unsigned*)((const char*)(gbase) + (h64) + (o0)), (LAS unsigned*)(lds + (bufoff) + ldsw + 8192), 16, 0, 0); } while (0)
#define G_LDA(dst, b, h) do { _Pragma("unroll") for (int m = 0; m < 4; ++m) _Pragma("unroll") for (int k = 0; k < 2; ++k) dst[m][k] = *(const LAS bf16x8*)(lds + G_SA(b, h) + aoff + m * 2048 + k * 1024); } while (0)
#define G_LDB(dst, b, h) do { _Pragma("unroll") for (int n = 0; n < 2; ++n) _Pragma("unroll") for (int k = 0; k < 2; ++k) dst[n][k] = *(const LAS bf16x8*)(lds + G_SB(b, h) + boff + n * 2048 + k * 1024); } while (0)
#define G_MMA(ai, bj, At, Bt) do { __builtin_amdgcn_s_setprio(1); _Pragma("unroll") for (int m = 0; m < 4; ++m) _Pragma("unroll") for (int n = 0; n < 2; ++n) _Pragma("unroll") for (int k = 0; k < 2; ++k) { \
        if constexpr (FP8) acc[ai][bj][m][n] = mma_fp8(Bt[n][k], At[m][k], acc[ai][bj][m][n]); \
        else acc[ai][bj][m][n] = __builtin_amdgcn_mfma_f32_16x16x32_bf16(Bt[n][k], At[m][k], acc[ai][bj][m][n], 0, 0, 0); } __builtin_amdgcn_s_setprio(0); } while (0)
#define G_WAIT_V(n) asm volatile("s_waitcnt vmcnt(" #n ")" ::: "memory")
#define G_WAIT_L(n) asm volatile("s_waitcnt lgkmcnt(" #n ")" ::: "memory")
#define G_BAR __builtin_amdgcn_s_barrier()
#define G_SCHED __builtin_amdgcn_sched_barrier(0)
    Unit cur, nxt; int ui = 0;
    if (!sched_next<PH, SUB>(E.ws, E.layer, 0, cur, E.x)) return;
    f32x4 acc[2][2][4][2];
#pragma unroll
    for (int a = 0; a < 2; ++a)
#pragma unroll
        for (int b = 0; b < 2; ++b)
#pragma unroll
            for (int m = 0; m < 4; ++m)
#pragma unroll
                for (int n = 0; n < 2; ++n) acc[a][b][m][n] = (f32x4){0.f, 0.f, 0.f, 0.f};
    bf16x8 At[4][2], B0[2][2], B1[2][2];
    const char* cA = cur.A; const char* cB = cur.B;
    G_STAGE(G_SB(0, 0), cB, cB0, qB); G_STAGE(G_SA(0, 0), cA, cA0, qA); G_STAGE(G_SB(0, 1), cB + chB, cB0, qB); G_STAGE(G_SA(0, 1), cA + chA, cA0, qA);
    if (wr == 1) G_BAR;
    G_WAIT_V(4); G_BAR;
    G_STAGE(G_SB(1, 0), cB + kB, cB0, qB); G_STAGE(G_SA(1, 0), cA + ckA, cA0, qA); G_STAGE(G_SB(1, 1), cB + chB + kB, cB0, qB);
    G_WAIT_V(6); G_BAR;
    for (;;) {
        const bool has_next = sched_next<PH, SUB>(E.ws, E.layer, ui + 1, nxt, E.x);
        if (!has_next) nxt = cur;
        const char* nA = nxt.A; const char* nB = nxt.B;
#pragma unroll 1
        for (int t = 0; t < nt; t += 2) {
            const bool last = (t == nt - 2);
            const char* a1 = cA + (size_t)(t + 1) * ckA;
            const char* a2 = last ? nA : cA + (size_t)(t + 2) * ckA; const char* b2 = last ? nB : cB + (size_t)(t + 2) * kB;
            const char* a3 = a2 + ckA; const char* b3 = b2 + kB;
            G_LDB(B0, 0, 0); G_SCHED; G_LDA(At, 0, 0); G_STAGE(G_SA(1, 1), a1 + chA, cA0, qA);
            G_WAIT_L(8); G_BAR; G_WAIT_L(0); G_MMA(0, 0, At, B0); G_BAR; G_SCHED;
            G_LDB(B1, 0, 1); G_STAGE(G_SB(0, 0), b2, cB0, qB);
            G_BAR; G_WAIT_L(0); G_MMA(0, 1, At, B1); G_BAR;
            G_LDA(At, 0, 1); G_STAGE(G_SA(0, 0), a2, cA0, qA);
            G_BAR; G_WAIT_L(0); G_MMA(1, 0, At, B0); G_BAR; G_SCHED;
            G_STAGE(G_SB(0, 1), b2 + chB, cB0, qB);
            G_WAIT_V(6); G_BAR; G_MMA(1, 1, At, B1); G_BAR;
            G_LDB(B0, 1, 0); G_SCHED; G_LDA(At, 1, 0); G_STAGE(G_SA(0, 1), a2 + chA, cA0, qA);
            G_WAIT_L(8); G_BAR; G_WAIT_L(0); G_MMA(0, 0, At, B0); G_BAR; G_SCHED;
            G_LDB(B1, 1, 1); G_STAGE(G_SB(1, 0), b3, cB0, qB);
            G_BAR; G_WAIT_L(0); G_MMA(0, 1, At, B1); G_BAR;
            G_LDA(At, 1, 1); G_STAGE(G_SA(1, 0), a3, cA0, qA);
            G_BAR; G_WAIT_L(0); G_MMA(1, 0, At, B0); G_BAR; G_SCHED;
            G_STAGE(G_SB(1, 1), b3 + chB, cB0, qB);
            G_WAIT_V(6); G_BAR; G_MMA(1, 1, At, B1); G_BAR;
        }
        E.template run<cs.kind>(acc, cur, tid);
        if (!has_next) break;
        if (!(cs.kind == K_MG_B && cur.aux < 2))
#pragma unroll
        for (int a = 0; a < 2; ++a)
#pragma unroll
            for (int b = 0; b < 2; ++b)
#pragma unroll
                for (int m = 0; m < 4; ++m)
#pragma unroll
                    for (int n = 0; n < 2; ++n) acc[a][b][m][n] = (f32x4){0.f, 0.f, 0.f, 0.f};
        cur = nxt; cA = nA; cB = nB; ++ui;
    }
    G_WAIT_V(0);
    if (wr == 0) G_BAR;
    G_BAR;
#undef G_SA
#undef G_SB
#undef G_STAGE
#undef G_LDA
#undef G_LDB
#undef G_MMA
#undef G_WAIT_V
#undef G_WAIT_L
#undef G_BAR
#undef G_SCHED
}

__device__ __forceinline__ void convert_job(unsigned char* smem, const float* src, int ld, int col0, int mapkind, int N, int K, const float* scale, bf16_t* dst, int vb, int vG) {
    const int tidx = ltid();
    bf16_t* tile = (bf16_t*)smem;
    const int w = tidx >> 6, lane = tidx & 63;
    const int tn = N / 64, tk = K / 256, ntile = tn * tk;
    for (int t = vb; t < ntile; t += vG) {
        const int n0 = (t % tn) * 64, k0 = (t / tn) * 256;
        const int np = n0 + lane; int sc;
        if (mapkind == 0) sc = col0 + np;
        else if (mapkind == 2) { if (np >= 1024 && np < 2048) { const int pq = (np - 1024) >> 8, c = np & 255; sc = (c < 128) ? (1024 + pq * 128 + c) : (1536 + pq * 128 + (c - 128)); } else sc = np; }
        else { const int pn = np >> 8, c = np & 255; sc = (c < 128) ? (pn * 128 + c) : (FFH + pn * 128 + (c - 128)); }
        float v[32];
#pragma unroll
        for (int rr = 0; rr < 32; ++rr) v[rr] = src[(size_t)(k0 + w * 32 + rr) * ld + sc];
        if (scale) {
#pragma unroll
            for (int rr = 0; rr < 32; ++rr) v[rr] *= scale[k0 + w * 32 + rr]; }
#pragma unroll
        for (int rr = 0; rr < 32; rr += 2) *(unsigned*)(tile + lane * 258 + w * 32 + rr) = cvt_pk_bf16(v[rr], v[rr + 1]);
        __syncthreads();
#pragma unroll
        for (int i = 0; i < 4; ++i) { const int idx = tidx + i * 512, nn = idx >> 5, k8 = idx & 31; const unsigned* tp = (const unsigned*)(tile + nn * 258 + k8 * 8); u32x4 o; o.x = tp[0]; o.y = tp[1]; o.z = tp[2]; o.w = tp[3];
            *(u32x4*)(dst + (size_t)(n0 + nn) * K + k0 + k8 * 8) = o; }
        __syncthreads();
    }
}
__device__ __forceinline__ void convert_layer(unsigned char* smem, const Params& P, int layer, int skip) {
    const int tidx = ltid();
    if ((int)blockIdx.x < skip) return;
    const int vb = blockIdx.x - skip, vG = gridDim.x - skip;
    bf16_t* wb = (bf16_t*)(P.ws + OFF_WB + (size_t)(layer & 1) * WB_BYTES);
    convert_job(smem, P.w_in + (size_t)layer * DM * INW, INW, 0, 2, ZW, DM, P.norm_mix + layer * DM, wb + W_IN, vb, vG);
    { const float* src = P.w_in + (size_t)layer * DM * INW + ZW; const float* gain = P.norm_mix + layer * DM; unsigned char* dst = (unsigned char*)(wb + W_G);
      for (size_t idx = (size_t)vb * 512 + tidx; idx < (size_t)3072 * 128; idx += (size_t)vG * 512) { const int n = (int)(idx % 3072), k8 = (int)(idx / 3072); float v[8];
#pragma unroll
          for (int j = 0; j < 8; ++j) v[j] = src[(size_t)(k8 * 8 + j) * INW + n] * gain[k8 * 8 + j] * GATE_WSCALE;
          u32x2 w8; w8.x = pack4_fp8(v[0], v[1], v[2], v[3]); w8.y = pack4_fp8(v[4], v[5], v[6], v[7]); *(u32x2*)(dst + (size_t)n * 1024 + k8 * 8) = w8; } }
    convert_job(smem, P.w_glu + (size_t)layer * 512 * 512, 512, 0, 0, 512, 512, nullptr, wb + W_GLU, vb, vG);
    for (int r = 0; r < 3; ++r) convert_job(smem, P.w_branch + ((size_t)layer * 3 + r) * 512 * 1024, 1024, 0, 0, 1024, 512, nullptr, wb + W_BR + (size_t)r * 1024 * 512, vb, vG);
    convert_job(smem, P.w_out + (size_t)layer * DM * DM, DM, 0, 0, DM, DM, nullptr, wb + W_OUT, vb, vG);
    convert_job(smem, P.w_ffn_in + (size_t)layer * DM * 2 * FFH, 2 * FFH, 0, 1, 2 * FFH, DM, P.norm_ffn + layer * DM, wb + W_FFI, vb, vG);
    convert_job(smem, P.w_ffn_out + (size_t)layer * FFH * DM, DM, 0, 0, DM, FFH, nullptr, wb + W_FFO, vb, vG);
    convert_job(smem, P.w_ple_gate + (size_t)layer * DM * DM, DM, 0, 0, DM, DM, P.norm_ple + layer * DM, wb + W_PG, vb, vG);
    convert_job(smem, P.w_ple_proj + (size_t)layer * 256 * DM, DM, 0, 0, DM, 256, nullptr, wb + W_PP, vb, vG);
    const f32x4* ps = (const f32x4*)(P.p + (size_t)layer * T_TOK * 256); u32x4* pd = (u32x4*)(P.ws + OFF_PB + (size_t)(layer & 1) * PB_BYTES);
    for (size_t i = (size_t)vb * 512 + tidx; i < (size_t)T_TOK * 256 / 8; i += (size_t)vG * 512) pd[i] = pack8(ps[2 * i], ps[2 * i + 1]);
}

__device__ __forceinline__ void a_pow(float lr, float li, float dt, int tau, float& re, float& im) {
    const float mag = __expf(lr * dt * (float)tau);
    double rev = (double)li * (double)dt * (double)tau * 0.15915494309189535; rev -= rint(rev);
    const double q = rint(rev * 4.0), th = (rev * 4.0 - q) * 1.5707963267948966, t2 = th * th;
    const double sn = th * (1.0 + t2 * (-1.0 / 6 + t2 * (1.0 / 120 + t2 * (-1.0 / 5040 + t2 * (1.0 / 362880 + t2 * (-1.0 / 39916800))))));
    const double cs = 1.0 + t2 * (-0.5 + t2 * (1.0 / 24 + t2 * (-1.0 / 720 + t2 * (1.0 / 40320 + t2 * (-1.0 / 3628800 + t2 * (1.0 / 479001600))))));
    const int qi = ((int)q) & 3; double c, s;
    if (qi == 0) { c = cs; s = sn; } else if (qi == 1) { c = -sn; s = cs; } else if (qi == 2) { c = -cs; s = -sn; } else { c = sn; s = -cs; }
    re = mag * (float)c; im = mag * (float)s;
}
__device__ __forceinline__ void ssm_group_tables(const Params& P, int layer, int g, int tau0, int ntau, float2* AT, float2* BB, float2* CC) {
    const int tidx = ltid();
    const int tid = tidx; const size_t gl = (size_t)layer * 32 + g;
    const float dt = __expf(P.log_dt[gl]);
    for (int i = tid; i < ntau * 64; i += 512) { const int tau = tau0 + i / 64, n = i % 64; float re, im; a_pow(P.lam_re[gl * 64 + n], P.lam_im[gl * 64 + n], dt, tau, re, im); AT[i] = make_float2(re, im); }
    for (int i = tid; i < 1024; i += 512) { const int n = i >> 4;
        const float lr = P.lam_re[gl * 64 + n], li = P.lam_im[gl * 64 + n]; float ar, ai; a_pow(lr, li, dt, 1, ar, ai);
        const float den = lr * lr + li * li, nr = ar - 1.0f, cr = (nr * lr + ai * li) / den, ci = (ai * lr - nr * li) / den;
        const float br = P.b_re[gl * 1024 + i], bi = P.b_im[gl * 1024 + i];
        BB[i] = make_float2(cr * br - ci * bi, cr * bi + ci * br);
        CC[i] = make_float2(P.c_re[gl * 1024 + i], P.c_im[gl * 1024 + i]); }
}
__device__ __forceinline__ void ssm_ktable(unsigned char* smem, const Params& P) {
    const int tidx = ltid();
    float2* AT = (float2*)smem; float2* BB = AT + 4 * 64; float2* CC = BB + 1024;
    float* Kt = (float*)(P.ws + OFF_KT);
    for (int job = blockIdx.x; job < N_LAYERS * 256; job += gridDim.x) { const int layer = job >> 8, g = (job >> 3) & 31, sub = job & 7;
        __syncthreads(); ssm_group_tables(P, layer, g, 4 * sub, 4, AT, BB, CC); __syncthreads();
        for (int i = tidx; i < 1024; i += 512) { const int tl = i >> 8, p = (i >> 4) & 15, q = i & 15; float s = 0.f;
            for (int n = 0; n < 64; ++n) { const float2 a = AT[tl * 64 + n], b = BB[n * 16 + q], c = CC[p * 64 + n]; const float wr_ = a.x * b.x - a.y * b.y, wi_ = a.x * b.y + a.y * b.x; s += c.x * wr_ - c.y * wi_; }
            Kt[((size_t)(layer * 32 + g) * 32 + 4 * sub + tl) * 256 + (i & 255)] = s; } }
}
__device__ __forceinline__ void ssm_group_tables_all(const Params& P) {
    for (int job = blockIdx.x; job < N_LAYERS * 32; job += gridDim.x) { float2* base = (float2*)(P.ws + OFF_GT) + (size_t)job * 4160;
        ssm_group_tables(P, job >> 5, job & 31, 0, 33, base, base + 33 * 64, base + 33 * 64 + 1024); }
}
__device__ __forceinline__ void ssm_tables(unsigned char* smem, const Params& P, int layer, int job0, int job1, int jstep) {
    const int tidx = ltid();
    float2* AT = (float2*)smem; float2* BB = AT + 33 * 64; float2* CC = BB + 1024;
    const float* Kt = (const float*)(P.ws + OFF_KT) + (size_t)layer * 32 * 8192; const int tid = tidx;
    for (int job = job0; job < job1; job += jstep) { const int g = job >> 3, sub = job & 7;
        __syncthreads(); { const float2* src = (const float2*)(P.ws + OFF_GT) + (size_t)(layer * 32 + g) * 4160; for (int i = tid; i < 4160; i += 512) AT[i] = src[i]; } __syncthreads();
        bf16_t* Tg = (bf16_t*)(P.ws + OFF_TG) + (size_t)g * 768 * 512; bf16_t* Mo = (bf16_t*)(P.ws + OFF_MO) + (size_t)g * 512 * 256; const float* Kg = Kt + (size_t)g * 8192;
        for (int i = tid; i < 64 * 64; i += 512) { const int rl = i >> 6, pc = i & 63, t = 4 * sub + (rl >> 4), p = rl & 15, s = pc >> 1, q0 = (pc & 1) * 8; u32x4 w = {0u, 0u, 0u, 0u};
            if (t >= s) { const float* kp = Kg + (size_t)(t - s) * 256 + p * 16 + q0; w = pack8(*(const f32x4*)kp, *(const f32x4*)(kp + 4)); }
            *(u32x4*)(Tg + (size_t)(t * 16 + p) * 512 + pc * 8) = w; }
        for (int i = tid; i < 16 * 64; i += 512) { const int np = 16 * sub + (i >> 6), pc = i & 63, n = np & 63, s = pc >> 1, q0 = (pc & 1) * 8; const float2 a = AT[(LCH - 1 - s) * 64 + n]; f32x4 v0, v1;
#pragma unroll
            for (int j = 0; j < 8; ++j) { const float2 b = BB[n * 16 + q0 + j]; const float val = (np < 64) ? (a.x * b.x - a.y * b.y) : (a.x * b.y + a.y * b.x); if (j < 4) v0[j] = val; else v1[j - 4] = val; }
            *(u32x4*)(Tg + (size_t)(512 + np) * 512 + pc * 8) = pack8(v0, v1);
            *(u32x4*)(Tg + (size_t)(640 + np) * 512 + pc * 8) = (u32x4){0u, 0u, 0u, 0u}; }
        for (int i = tid; i < 64 * 32; i += 512) { const int rl = i >> 5, pc = i & 31, t = 4 * sub + (rl >> 4), p = rl & 15; u32x4 w = {0u, 0u, 0u, 0u};
            if (pc < 16) { const int n0 = (pc & 7) * 8; f32x4 v0, v1;
#pragma unroll
                for (int j = 0; j < 8; ++j) { const float2 a = AT[(t + 1) * 64 + n0 + j], c = CC[p * 64 + n0 + j]; const float val = (pc < 8) ? (c.x * a.x - c.y * a.y) : -(c.x * a.y + c.y * a.x); if (j < 4) v0[j] = val; else v1[j - 4] = val; }
                w = pack8(v0, v1); }
            *(u32x4*)(Mo + (size_t)(t * 16 + p) * 256 + pc * 8) = w; }
        if (sub == 0 && tid < 64) ((float2*)(P.ws + OFF_AL))[g * 64 + tid] = AT[LCH * 64 + tid];
    }
}
__device__ __forceinline__ void ssm_scan(const Params& P) {
    const int tidx = ltid();
    const int gt = blockIdx.x * 512 + tidx; if (gt >= 8192) return;
    const int b = gt >> 11, g = (gt >> 6) & 31, n = gt & 63;
    float2 a; { unsigned* ap = (unsigned*)(P.ws + OFF_AL) + (g * 64 + n) * 2; a.x = __uint_as_float(__hip_atomic_load(ap, __ATOMIC_RELAXED, __HIP_MEMORY_SCOPE_AGENT)); a.y = __uint_as_float(__hip_atomic_load(ap + 1, __ATOMIC_RELAXED, __HIP_MEMORY_SCOPE_AGENT)); }
    const float* S = (const float*)(P.ws + OFF_S); bf16_t* H = (bf16_t*)(P.ws + OFF_H);
    float hr = 0.f, hi = 0.f;
    for (int c0 = 0; c0 < 256; c0 += 32) { float sr[32], si[32];
#pragma unroll
        for (int j = 0; j < 32; ++j) { const size_t o = ((size_t)(b * 256 + c0 + j) * 32 + g) * 128 + n; sr[j] = S[o]; si[j] = S[o + 64]; }
#pragma unroll
        for (int j = 0; j < 32; ++j) { bf16_t* hp = H + ((size_t)(b * 256 + c0 + j) * 32 + g) * 256 + n; const unsigned w = cvt_pk_bf16(hr, hi);
            hp[0] = (bf16_t)(w & 0xffff); hp[64] = (bf16_t)(w >> 16); hp[128] = 0; hp[192] = 0;
            const float nr = a.x * hr - a.y * hi + sr[j], ni = a.x * hi + a.y * hr + si[j]; hr = nr; hi = ni; } }
}

__device__ __forceinline__ void conv_phase(const Params& P, int layer) {
    const int tidx = ltid();
    bf16_t* zb = (bf16_t*)(P.ws + OFF_ZB); const float* cw = P.conv_w + (size_t)layer * 3 * 512;
    const int c8 = (tidx & 63) * 8;
    f32x4 w[3][2];
#pragma unroll
    for (int d = 0; d < 3; ++d) { w[d][0] = *(const f32x4*)(cw + d * 512 + c8); w[d][1] = *(const f32x4*)(cw + d * 512 + c8 + 4); }
    for (int run = blockIdx.x * 8 + (tidx >> 6); run < T_TOK / 16; run += gridDim.x * 8) {
        const size_t t0 = (size_t)run * 16; const int s0 = (int)(t0 & 8191);
        bf16_t* base = zb + t0 * ZW + c8;
        f32x4 v1[2] = {{0.f, 0.f, 0.f, 0.f}, {0.f, 0.f, 0.f, 0.f}}, v2[2] = {{0.f, 0.f, 0.f, 0.f}, {0.f, 0.f, 0.f, 0.f}};
        if (s0 > 0) { unpack8(*(const u32x4*)(base - (size_t)ZW + 1024), v1[0], v1[1]); unpack8(*(const u32x4*)(base - (size_t)2 * ZW + 1024), v2[0], v2[1]); }
#pragma unroll
        for (int q = 0; q < 4; ++q) { u32x4 cbv[4], vv[4];
#pragma unroll
            for (int j = 0; j < 4; ++j) { bf16_t* bp = base + (size_t)(q * 4 + j) * ZW; cbv[j] = *(const u32x4*)(bp + 512); vv[j] = *(const u32x4*)(bp + 1024); }
#pragma unroll
            for (int j = 0; j < 4; ++j) { f32x4 v00, v01, g0, g1; unpack8(vv[j], v00, v01); unpack8(cbv[j], g0, g1);
                const f32x4 y0 = g0 * (w[0][0] * v2[0] + w[1][0] * v1[0] + w[2][0] * v00), y1 = g1 * (w[0][1] * v2[1] + w[1][1] * v1[1] + w[2][1] * v01);
                *(u32x4*)(base + (size_t)(q * 4 + j) * ZW + 512) = pack8(y0, y1);
                v2[0] = v1[0]; v2[1] = v1[1]; v1[0] = v00; v1[1] = v01; } }
    }
}

__device__ __forceinline__ void attn_phase(unsigned char* smem, const Params& P, int layer) {
    const int tidx = ltid();
    bf16_t* Kl = (bf16_t*)smem;
    bf16_t* Vl = (bf16_t*)(smem + 256 * 72 * 2);
    float* Bl = (float*)(smem + 256 * 72 * 2 + 64 * 264 * 2);
    bf16_t* zb = (bf16_t*)(P.ws + OFF_ZB); const bf16_t* vT = (const bf16_t*)(P.ws + OFF_VT); const float* biasd = (const float*)(P.ws + OFF_BIAS);
    const int tid = tidx, w = tid >> 6, lane = tid & 63, ql = lane & 15, q4 = lane >> 4;
    for (int item = blockIdx.x; item < 512; item += gridDim.x) {
        const int b = item >> 7, blk = (item & 127) >> 1, kvh = item & 1, s0 = blk * 128;
        __syncthreads();
        for (int pc = tid; pc < 2048; pc += 512) { const int key = pc >> 3, d8 = pc & 7, s = s0 - 128 + key; u32x4 v = {0u, 0u, 0u, 0u};
            if (s >= 0) v = *(const u32x4*)(zb + ((size_t)(b * SEQ + s)) * ZW + 2560 + kvh * 64 + d8 * 8);
            *(u32x4*)(Kl + key * 72 + d8 * 8) = v; }
        for (int pc = tid; pc < 2048; pc += 512) { const int d = pc >> 5, k8 = pc & 31, s = s0 - 128 + k8 * 8; u32x4 v = {0u, 0u, 0u, 0u};
            if (s >= 0) v = *(const u32x4*)(vT + ((size_t)(b * 128 + kvh * 64 + d)) * SEQ + s);
            *(u32x4*)(Vl + d * 264 + k8 * 8) = v; }
        Bl[tid] = biasd[(kvh * 4 + (tid >> 7)) * 128 + (tid & 127)];
        __syncthreads();
        const bf16_t* qbase = zb + (size_t)(b * SEQ + s0 + 16 * w + ql) * ZW + 2048 + kvh * 256 + q4 * 8;
        bf16x8 Qn0 = *(const bf16x8*)(qbase), Qn1 = *(const bf16x8*)(qbase + 32);
        for (int g = 0; g < 4; ++g) { const int h = kvh * 4 + g;
            const bf16x8 Q0 = Qn0, Q1 = Qn1;
            if (g < 3) { Qn0 = *(const bf16x8*)(qbase + (g + 1) * 64); Qn1 = *(const bf16x8*)(qbase + (g + 1) * 64 + 32); }
            const float sink = P.sinks[layer * 8 + h];
            f32x4 sc[10]; float mx = sink;
#pragma unroll
            for (int tt = 0; tt < 10; ++tt) { const int tl = w + tt, tc = tl < 15 ? tl : 15;
                const bf16x8 K0 = *(const bf16x8*)(Kl + (16 * tc + ql) * 72 + q4 * 8), K1 = *(const bf16x8*)(Kl + (16 * tc + ql) * 72 + 32 + q4 * 8);
                f32x4 a = {0.f, 0.f, 0.f, 0.f}; a = __builtin_amdgcn_mfma_f32_16x16x32_bf16(K0, Q0, a, 0, 0, 0); a = __builtin_amdgcn_mfma_f32_16x16x32_bf16(K1, Q1, a, 0, 0, 0);
#pragma unroll
                for (int j = 0; j < 4; ++j) { const int dist = ql + 128 - 16 * tt - 4 * q4 - j, kj = 16 * tl + 4 * q4 + j;
                    const bool valid = (dist >= 0) && (dist < 128) && (tl < 16) && (blk > 0 || kj >= 128);
                    const float sv = valid ? (a[j] * 0.125f + Bl[g * 128 + (dist & 127)]) : -INFINITY; a[j] = sv; mx = fmaxf(mx, sv); }
                sc[tt] = a; }
            mx = fmaxf(mx, __shfl_xor(mx, 16)); mx = fmaxf(mx, __shfl_xor(mx, 32));
            float l = 0.f;
#pragma unroll
            for (int tt = 0; tt < 10; ++tt)
#pragma unroll
                for (int j = 0; j < 4; ++j) { const float pv = __expf(sc[tt][j] - mx); sc[tt][j] = pv; l += pv; }
            l += __shfl_xor(l, 16); l += __shfl_xor(l, 32); l += __expf(sink - mx);
            const float linv = 1.0f / l;
            f32x4 o[4];
#pragma unroll
            for (int dt = 0; dt < 4; ++dt) o[dt] = (f32x4){0.f, 0.f, 0.f, 0.f};
#pragma unroll
            for (int pp = 0; pp < 5; ++pp) { const int tA = w + 2 * pp, tB = tA + 1, cA_ = tA < 15 ? tA : 15, cB_ = tB < 15 ? tB : 15;
                u32x4 pw; pw.x = cvt_pk_bf16(sc[2 * pp][0], sc[2 * pp][1]); pw.y = cvt_pk_bf16(sc[2 * pp][2], sc[2 * pp][3]); pw.z = cvt_pk_bf16(sc[2 * pp + 1][0], sc[2 * pp + 1][1]); pw.w = cvt_pk_bf16(sc[2 * pp + 1][2], sc[2 * pp + 1][3]);
                bf16x8 Pf; __builtin_memcpy(&Pf, &pw, 16);
#pragma unroll
                for (int dt = 0; dt < 4; ++dt) { const bf16_t* vr = Vl + (16 * dt + ql) * 264 + 4 * q4; const u32x2 va = *(const u32x2*)(vr + 16 * cA_), vb = *(const u32x2*)(vr + 16 * cB_);
                    u32x4 vw; vw.x = va.x; vw.y = va.y; vw.z = vb.x; vw.w = vb.y; bf16x8 Vf; __builtin_memcpy(&Vf, &vw, 16);
                    o[dt] = __builtin_amdgcn_mfma_f32_16x16x32_bf16(Pf, Vf, o[dt], 0, 0, 0); } }
#pragma unroll
            for (int j = 0; j < 4; ++j) { const float li = __shfl(linv, 4 * q4 + j); bf16_t* op = zb + ((size_t)(b * SEQ + s0 + 16 * w + 4 * q4 + j)) * ZW + 2048 + h * 64 + ql;
#pragma unroll
                for (int dt = 0; dt < 4; ++dt) op[16 * dt] = (bf16_t)(cvt_pk_bf16(o[dt][j] * li, 0.f) & 0xffff); }
        }
    }
}

__device__ __forceinline__ void x_init(const Params& P) {
    const int tidx = ltid();
    const int lane = tidx & 63, gw = blockIdx.x * 8 + (tidx >> 6), nw = gridDim.x * 8;
    bf16_t* xb0 = (bf16_t*)(P.ws + OFF_XB0); float* ssq0 = (float*)(P.ws + OFF_SSQ);
    for (int row = gw; row < T_TOK; row += nw) { float ss = 0.f;
#pragma unroll
        for (int k = 0; k < 4; ++k) { const size_t o = (size_t)row * 1024 + k * 256 + lane * 4; const f32x4 v = *(const f32x4*)(P.x + o);
            u32x2 w; w.x = cvt_pk_bf16(v[0], v[1]); w.y = cvt_pk_bf16(v[2], v[3]); *(u32x2*)(xb0 + o) = w;
            *(unsigned*)(P.ws + OFF_ZB + (size_t)row * (ZW * 2) + k * 256 + lane * 4) = pack4_fp8(v[0], v[1], v[2], v[3]); ss += (v[0] * v[0] + v[1] * v[1]) + (v[2] * v[2] + v[3] * v[3]); }
#pragma unroll
        for (int o = 32; o >= 1; o >>= 1) ss += __shfl_xor(ss, o);
        if (lane < 16) ssq0[((size_t)(lane >> 2) * T_TOK + row) * 4 + (lane & 3)] = lane == 0 ? ss : 0.f; }
}
__device__ __forceinline__ void bias_table(const Params& P) {
    const int tidx = ltid();
    if (blockIdx.x == 0) for (int i = tidx; i < 1024; i += 512) { const int h = i >> 7, dist = i & 127; int bucket;
        if (dist < 16) bucket = dist; else { bucket = 16 + (int)(logf((float)dist / 16.0f) / 2.0794415416798357f * 16.0f); bucket = bucket < 31 ? bucket : 31; }
        ((float*)(P.ws + OFF_BIAS))[i] = P.rel_bias[bucket * 8 + h]; }
}
__device__ __forceinline__ void final_norm(const Params& P) {
    const int tidx = ltid();
    const float* ssq0 = (const float*)(P.ws + OFF_SSQ); const bf16_t* xb0 = (const bf16_t*)(P.ws + OFF_XB0);
    const int lane = tidx & 63, gw = blockIdx.x * 8 + (tidx >> 6), nw = gridDim.x * 8;
    f32x4 g[4];
#pragma unroll
    for (int k = 0; k < 4; ++k) g[k] = *(const f32x4*)(P.norm_final + k * 256 + lane * 4);
    for (int row = gw; row < T_TOK; row += nw) {
        float t = 0.f; if (lane < 16) t = __uint_as_float(__hip_atomic_load((unsigned*)(ssq0 + ((size_t)(lane >> 2) * T_TOK + row) * 4 + (lane & 3)), __ATOMIC_RELAXED, __HIP_MEMORY_SCOPE_AGENT));
#pragma unroll
        for (int o = 8; o >= 1; o >>= 1) t += __shfl_xor(t, o);
        const float rs = rsqrtf(__shfl(t, 0) * (1.0f / 1024.0f) + 1e-6f);
#pragma unroll
        for (int k = 0; k < 4; ++k) { const size_t o = (size_t)row * 1024 + k * 256 + lane * 4; const u32x2 w = *(const u32x2*)(xb0 + o);
            f32x4 v; v[0] = bf_lo(w.x); v[1] = bf_hi(w.x); v[2] = bf_lo(w.y); v[3] = bf_hi(w.y); *(f32x4*)(P.out + o) = v * rs * g[k]; }
    }
}


#define XB_TMO      128
#define XB_XCNT(j)  (256  + 64 * (j))
#define XB_XSUB(j)  (1280 + 64 * (j))
#define XB_XGEN(j)  (2304 + 64 * (j))
#define XB_TOP      3328
#define XB_TOPGEN   3392
#define XCD_BAR_WORDS 3456
#define XB_SPIN_CAP (1u << 20)
__device__ __forceinline__ unsigned xb_ld(unsigned* p)              { return __hip_atomic_load(p, __ATOMIC_RELAXED, __HIP_MEMORY_SCOPE_AGENT); }
__device__ __forceinline__ unsigned xb_add(unsigned* p, unsigned v) { return __hip_atomic_fetch_add(p, v, __ATOMIC_RELAXED, __HIP_MEMORY_SCOPE_AGENT); }
__device__ __forceinline__ unsigned xb_xcc_id() { return (unsigned)__builtin_amdgcn_s_getreg((3 << 11) | 20) & 0xFu; }
#define XB_SPIN(cond, bar) do { unsigned _sp = 0; while (cond) { __builtin_amdgcn_s_sleep(1); \
    if ((++_sp & 255u) == 0u) { if (xb_ld(&(bar)[XB_TMO])) break; if (_sp > XB_SPIN_CAP) { atomicAdd(&(bar)[XB_TMO], 1u); break; } } } } while (0)
struct XcdBarrier { unsigned* bar; unsigned x; volatile LAS unsigned* st; };
__device__ __forceinline__ XcdBarrier xcd_barrier_post(unsigned* bar, volatile LAS unsigned* st) {
    XcdBarrier b; b.bar = bar; b.x = xb_xcc_id(); b.st = st;
    if (threadIdx.x == 0) (void)xb_add(&bar[XB_XCNT(b.x)], 1u);
    return b;
}
__device__ __forceinline__ void xcd_barrier_complete(unsigned* bar, unsigned x, unsigned& nloc, unsigned& nx) {
    const unsigned G = gridDim.x * gridDim.y * gridDim.z;
    unsigned sum, cnt, mine, sp = 0u;
    for (;;) {
        sum = 0u; cnt = 0u; mine = 0u;
#pragma unroll
        for (unsigned j = 0; j < 16; ++j) { const unsigned c = xb_ld(&bar[XB_XCNT(j)]); sum += c; cnt += (c > 0u) ? 1u : 0u; mine = (j == x) ? c : mine; }
        if (sum == G) break;
        __builtin_amdgcn_s_sleep(1);
        if ((++sp & 255u) == 0u) { if (xb_ld(&bar[XB_TMO])) break; if (sp > XB_SPIN_CAP) { atomicAdd(&bar[XB_TMO], 1u); break; } }
    }
    nloc = mine > 0u ? mine : 1u; nx = cnt > 0u ? cnt : 1u;
}
__device__ __forceinline__ void xcd_barrier(const XcdBarrier& b) {
    asm volatile("s_waitcnt vmcnt(0)" ::: "memory");
    __syncthreads();
    if (threadIdx.x == 0) {
        unsigned* bar = b.bar;
        __builtin_amdgcn_s_waitcnt(0);
        unsigned nloc = b.st[0], nx = b.st[1];
        if (nloc == 0u) { xcd_barrier_complete(bar, b.x, nloc, nx); b.st[0] = nloc; b.st[1] = nx; }
        const unsigned old = xb_add(&bar[XB_XSUB(b.x)], 1u);
        const unsigned gen = old / nloc;
        if (old + 1u == (gen + 1u) * nloc) {
            __builtin_amdgcn_fence(__ATOMIC_RELEASE, "agent");
            asm volatile("s_waitcnt vmcnt(0)" ::: "memory");
            const unsigned og = xb_add(&bar[XB_TOP], 1u);
            const unsigned tg = og / nx;
            if (og + 1u == (tg + 1u) * nx) xb_add(&bar[XB_TOPGEN], 1u);
            else XB_SPIN(xb_ld(&bar[XB_TOPGEN]) == tg, bar);
            __builtin_amdgcn_fence(__ATOMIC_ACQUIRE, "agent");
            xb_add(&bar[XB_XGEN(b.x)], 1u);
            asm volatile("s_waitcnt vmcnt(0)" ::: "memory");
        } else {
            XB_SPIN(xb_ld(&bar[XB_XGEN(b.x)]) == gen, bar);
            __builtin_amdgcn_fence(__ATOMIC_ACQUIRE, "agent");
            asm volatile("s_waitcnt vmcnt(0)" ::: "memory");
        }
    }
    __syncthreads();
}

typedef const Params __attribute__((address_space(4)))* CParams;
#define LOADP(Pl) Params Pl; { CParams q_ = pk; asm volatile("" : "+s"(q_)); Pl = *q_; }
#define MAKE_E(E, Pl) Epi E; E.ws = Pl.ws; E.x = Pl.out; E.dskip = Pl.ssm_d + layer * 512; E.layer = layer; E.rstab = (const LAS float*)(lds + STAGE_BYTES + 16);
__global__ void __launch_bounds__(512) fwd_megakernel(Params Parg) {
#if defined(__HIP_DEVICE_COMPILE__)
    cg::grid_group grid = cg::this_grid();
    extern __shared__ __attribute__((aligned(16))) unsigned char smem[];
    LAS unsigned char* lds = (LAS unsigned char*)smem;
    CParams pk = (CParams)__builtin_amdgcn_kernarg_segment_ptr();
    volatile LAS unsigned* xst = (volatile LAS unsigned*)(lds + STAGE_BYTES);
    if (threadIdx.x == 0) { xst[0] = 0u; xst[1] = 0u; }
    __syncthreads();
    XcdBarrier xb; { LOADP(P) xb = xcd_barrier_post((unsigned*)(P.ws + OFF_BAR), xst); }
    { LOADP(P) x_init(P); bias_table(P); }
    { LOADP(P) ssm_ktable(smem, P); }
    { LOADP(P) ssm_group_tables_all(P); }
    __syncthreads();
    { LOADP(P) convert_layer(smem, P, 0, 0); }
    if (pk->ws == nullptr) grid.sync();
    xcd_barrier(xb);
    for (int layer = 0; layer < N_LAYERS; ++layer) {
        { LOADP(P) MAKE_E(E, P) gemm_phase<PH_WIN>(lds, E); }
        if (gridDim.x == 256) { if (blockIdx.x >= 128) { LOADP(P) ssm_tables(smem, P, layer, (blockIdx.x - 128) * 2, (blockIdx.x - 128) * 2 + 2, 1); } }
        else { LOADP(P) ssm_tables(smem, P, layer, blockIdx.x, 256, gridDim.x); }
        xcd_barrier(xb);
        { LOADP(P) MAKE_E(E, P) gemm_phase<PH_SSM1>(lds, E); }
        { LOADP(P) attn_phase(smem, P, layer); }
        { LOADP(P) conv_phase(P, layer); }
        xcd_barrier(xb);
        { LOADP(P) ssm_scan(P); }
        if (layer + 1 < N_LAYERS) { LOADP(P) convert_layer(smem, P, layer + 1, 16); }
        xcd_barrier(xb);
        { LOADP(P) MAKE_E(E, P) gemm_phase<PH_SSM2>(lds, E); }
        xcd_barrier(xb);
        { LOADP(P) MAKE_E(E, P) gemm_phase<PH_GLU>(lds, E); }
        xcd_barrier(xb);
        { LOADP(P) MAKE_E(E, P) gemm_phase<PH_MERGE, 0>(lds, E); }
        { LOADP(P) MAKE_E(E, P) gemm_phase<PH_MERGE, 1>(lds, E); }
        xcd_barrier(xb);
        { LOADP(P) MAKE_E(E, P) gemm_phase<PH_WOUT>(lds, E); }
        xcd_barrier(xb);
        { LOADP(P) MAKE_E(E, P) gemm_phase<PH_FFI>(lds, E); }
        xcd_barrier(xb);
        { LOADP(P) MAKE_E(E, P) gemm_phase<PH_FFO>(lds, E); }
        xcd_barrier(xb);
        { LOADP(P) MAKE_E(E, P) gemm_phase<PH_PLE, 0>(lds, E); }
        { LOADP(P) MAKE_E(E, P) gemm_phase<PH_PLE, 1>(lds, E); }
        xcd_barrier(xb);
    }
    { LOADP(P) final_norm(P); }
#endif
}

extern "C" void kernel_launch(void* const* d_in, const int* in_sizes, int n_in, void* d_out, int out_size, void* d_ws, size_t ws_size, hipStream_t stream) {
    constexpr size_t kDynLds = STAGE_BYTES + 16 + 12 * 1024;
    static int grid_blocks = 0;
    if (!grid_blocks) {
        int dev = 0, cus = 0, per_cu = 0;
        hipGetDevice(&dev);
        hipDeviceGetAttribute(&cus, hipDeviceAttributeMultiprocessorCount, dev);
        hipFuncSetAttribute((const void*)fwd_megakernel, hipFuncAttributeMaxDynamicSharedMemorySize, (int)kDynLds);
        hipOccupancyMaxActiveBlocksPerMultiprocessor(&per_cu, fwd_megakernel, 512, kDynLds);
        if (per_cu < 1) per_cu = 1;
        grid_blocks = cus * 1;
    }
    Params P{};
    const float** f = (const float**)&P;
    for (int i = 0; i < 25; ++i) f[i] = (const float*)d_in[i];
    P.out = (float*)d_out; P.ws = (unsigned char*)d_ws;
    (void)hipMemsetAsync((char*)d_ws + OFF_BAR, 0, XCD_BAR_WORDS * sizeof(unsigned), stream);
    void* args[] = {&P};
    hipError_t e = hipLaunchCooperativeKernel((void*)fwd_megakernel, dim3(grid_blocks), dim3(512), args, kDynLds, stream);
    if (e != hipSuccess) fprintf(stderr, "cooperative launch failed: %s (grid %d)\n", hipGetErrorString(e), grid_blocks);
}
```

```cpp
#include <hip/hip_runtime.h>
#include <hip/hip_cooperative_groups.h>
#include <cstdio>
namespace cg = cooperative_groups;

#define LAS __attribute__((address_space(3)))
typedef unsigned short bf16_t;
typedef short bf16x8 __attribute__((ext_vector_type(8)));
typedef float f32x4 __attribute__((ext_vector_type(4)));
typedef unsigned u32x4 __attribute__((ext_vector_type(4)));
typedef unsigned u32x2 __attribute__((ext_vector_type(2)));

#ifndef N_LAYERS
#define N_LAYERS 4
#endif

constexpr int T_TOK = 32768, SEQ = 8192, DM = 1024, ZW = 2816, INW = 5888, FFH = 2816;
constexpr int LCH = 32;
constexpr size_t MiB = 1048576;
constexpr size_t OFF_WB = 0, WB_BYTES = 36 * MiB, OFF_PB = 72 * MiB, PB_BYTES = 16 * MiB, OFF_XB0 = 104 * MiB, OFF_SSQ = 168 * MiB, SSQ_BYTES = 2 * MiB,
                 OFF_ZB = 174 * MiB, OFF_YI = 350 * MiB, OFF_MG = 382 * MiB, OFF_TG = 446 * MiB, OFF_MO = 470 * MiB, OFF_S = 478 * MiB, OFF_H = 494 * MiB,
                 OFF_VT = 510 * MiB, OFF_KT = 518 * MiB, OFF_AL = 522 * MiB, OFF_BIAS = 522 * MiB + 65536, OFF_GT = 523 * MiB, OFF_BAR = 528 * MiB;
constexpr size_t W_IN = 0, W_G = 2883584, W_GLU = 6029312, W_BR = 6291456, W_OUT = 7864320, W_FFI = 8912896, W_FFO = 14680064, W_PG = 17563648, W_PP = 18612224;

struct Params {
    const float *x, *p, *rel_bias, *norm_mix, *w_in, *lam_re, *lam_im, *b_re, *b_im, *c_re, *c_im, *ssm_d, *log_dt, *w_glu, *conv_w, *sinks, *w_branch, *w_out,
        *norm_ffn, *w_ffn_in, *w_ffn_out, *norm_ple, *w_ple_gate, *w_ple_proj, *norm_final;
    float* out; unsigned char* ws;
};

__device__ __forceinline__ int ltid() { int t = threadIdx.x; asm volatile("" : "+v"(t)); return t; }
__device__ __forceinline__ unsigned cvt_pk_bf16(float lo, float hi) { unsigned r; asm volatile("v_cvt_pk_bf16_f32 %0, %1, %2" : "=v"(r) : "v"(lo), "v"(hi)); return r; }
__device__ __forceinline__ float bf_lo(unsigned w) { return __uint_as_float(w << 16); }
__device__ __forceinline__ float bf_hi(unsigned w) { return __uint_as_float(w & 0xffff0000u); }
__device__ __forceinline__ float sigmoidf_(float v) { return __builtin_amdgcn_rcpf(1.0f + __expf(-v)); }
__device__ __forceinline__ float gelu_tanh(float y) { const float z = 1.5957691216057308f * (y + 0.044715f * y * y * y); return y * sigmoidf_(z); }
__device__ __forceinline__ u32x4 pack8(const f32x4 a, const f32x4 b) { u32x4 w; w.x = cvt_pk_bf16(a[0], a[1]); w.y = cvt_pk_bf16(a[2], a[3]); w.z = cvt_pk_bf16(b[0], b[1]); w.w = cvt_pk_bf16(b[2], b[3]); return w; }
__device__ __forceinline__ void unpack8(const u32x4 w, f32x4& a, f32x4& b) { a[0] = bf_lo(w.x); a[1] = bf_hi(w.x); a[2] = bf_lo(w.y); a[3] = bf_hi(w.y); b[0] = bf_lo(w.z); b[1] = bf_hi(w.z); b[2] = bf_lo(w.w); b[3] = bf_hi(w.w); }
__device__ __forceinline__ unsigned pack4_u8(const f32x4 v) { const unsigned q0 = (unsigned)(v[0] * 255.0f + 0.5f), q1 = (unsigned)(v[1] * 255.0f + 0.5f), q2 = (unsigned)(v[2] * 255.0f + 0.5f), q3 = (unsigned)(v[3] * 255.0f + 0.5f);
    return q0 | (q1 << 8) | (q2 << 16) | (q3 << 24); }
__device__ __forceinline__ unsigned pack4_u8c(const f32x4 v) { const unsigned q0 = (unsigned)fmaxf(v[0] * 255.0f + 0.5f, 1.0f), q1 = (unsigned)fmaxf(v[1] * 255.0f + 0.5f, 1.0f), q2 = (unsigned)fmaxf(v[2] * 255.0f + 0.5f, 1.0f), q3 = (unsigned)fmaxf(v[3] * 255.0f + 0.5f, 1.0f);
    return q0 | (q1 << 8) | (q2 << 16) | (q3 << 24); }
__device__ __forceinline__ f32x4 unpack4_raw(const unsigned w) { f32x4 v; v[0] = (float)(w & 0xffu); v[1] = (float)((w >> 8) & 0xffu); v[2] = (float)((w >> 16) & 0xffu); v[3] = (float)(w >> 24); return v; }
__device__ __forceinline__ f32x4 unpack4_u8(const unsigned w) { f32x4 v; v[0] = (float)(w & 0xffu); v[1] = (float)((w >> 8) & 0xffu); v[2] = (float)((w >> 16) & 0xffu); v[3] = (float)(w >> 24); return v * (1.0f / 255.0f); }
__device__ __forceinline__ unsigned pack4_fp8(float a, float b, float c, float d) { unsigned w = 0u; w = __builtin_amdgcn_cvt_pk_fp8_f32(a, b, w, false); w = __builtin_amdgcn_cvt_pk_fp8_f32(c, d, w, true); return w; }
typedef long i64x2 __attribute__((ext_vector_type(2)));
__device__ __forceinline__ f32x4 mma_fp8(const bf16x8 b, const bf16x8 a, f32x4 c) { i64x2 bb, aa; __builtin_memcpy(&bb, &b, 16); __builtin_memcpy(&aa, &a, 16);
    c = __builtin_amdgcn_mfma_f32_16x16x32_fp8_fp8(bb.x, aa.x, c, 0, 0, 0); c = __builtin_amdgcn_mfma_f32_16x16x32_fp8_fp8(bb.y, aa.y, c, 0, 0, 0); return c; }
constexpr float GATE_WSCALE = 64.0f;
__device__ __forceinline__ float row_rs(const float* ssq, int row) {
    float s = 0.f;
#pragma unroll
    for (int pn = 0; pn < 4; ++pn)
#pragma unroll
        for (int j = 0; j < 4; ++j) s += __uint_as_float(__hip_atomic_load((unsigned*)(ssq + ((size_t)pn * T_TOK + row) * 4 + j), __ATOMIC_RELAXED, __HIP_MEMORY_SCOPE_AGENT));
    return rsqrtf(s * (1.0f / 1024.0f) + 1e-6f);
}

constexpr int BM = 256, BK = 64, HALF = 128, HTB = HALF * BK * 2, STAGE_BYTES = 8 * HTB;
__device__ __forceinline__ int lds_byte(int r, int c) { const int st = (r >> 4) * 2 + (c >> 5), rr = r & 15, cc = c & 31, ob = rr * 64 + cc * 2; return st * 1024 + (ob ^ (((ob >> 9) & 1) << 5)); }
__device__ __forceinline__ void stage_rc(int b, int& R, int& C) { const int st = b / 1024, sb = b % 1024, swz = sb ^ (((sb >> 9) & 1) << 5); R = (st >> 1) * 16 + swz / 64; C = (st & 1) * 32 + (swz % 64) / 2; }
__device__ __forceinline__ int perm32(int rho) { const int n = rho >> 4, i = rho & 15; return 8 * (i >> 2) + 4 * n + (i & 3); }

enum { K_WIN = 0, K_SSM1, K_SSM2, K_GLU, K_MG_G, K_MG_B, K_XADD, K_FFI, K_PP, K_PLE };
enum { PH_WIN = 0, PH_SSM1, PH_SSM2, PH_GLU, PH_MERGE, PH_WOUT, PH_FFI, PH_FFO, PH_PLE };

struct Unit {
    const char* A; const char* B;
    int pm, pn, aux, ord;
};
struct Shape { unsigned rsA, ssA, Kb; int nt, kind; };
template <int PH, int SUB> __device__ __forceinline__ constexpr Shape shape_of() {
    switch (PH) {
    case PH_WIN: return Shape{2048u, 32u, 1024u, 16, K_WIN};
    case PH_SSM1: return Shape{(unsigned)(LCH * 32), 32u, 512u, 8, K_SSM1};
    case PH_SSM2: return Shape{32u * 256u * 2u, 32u, 256u, 4, K_SSM2};
    case PH_GLU: return Shape{32u, (unsigned)(T_TOK * 32), 512u, 8, K_GLU};
    case PH_MERGE: return (SUB & 1) == 0 ? Shape{(unsigned)(ZW * 2), 32u, 512u, 8, K_MG_G} : Shape{(unsigned)(ZW * 2), 32u, 512u, 8, K_MG_B};
    case PH_WOUT: return Shape{2048u, 32u, 1024u, 16, K_XADD};
    case PH_FFI: return Shape{2048u, 32u, 1024u, 16, K_FFI};
    case PH_FFO: return Shape{(unsigned)(ZW * 2), 32u, (unsigned)FFH, 44, K_XADD};
    default: return SUB == 0 ? Shape{512u, 32u, 256u, 4, K_PP} : Shape{2048u, 32u, 1024u, 16, K_PLE};
    }
}

__device__ __forceinline__ void tile_map(int wgid, int nM, int nN, int& pm, int& pn) {
    const int nwg = nM * nN; { const int q = nwg / 8, r = nwg % 8, xcd = wgid % 8, off = wgid / 8; wgid = (xcd < r ? xcd * (q + 1) : r * (q + 1) + (xcd - r) * q) + off; }
    const int nig = 8 * nN, gid = wgid / nig, fm = gid * 8, gsz = (nM - fm) < 8 ? (nM - fm) : 8;
    pm = fm + ((wgid % nig) % gsz); pn = (wgid % nig) / gsz;
}

template <int PH, int SUB> __device__ __forceinline__ bool sched_next(unsigned char* ws, int layer, int i, Unit& u, const void* ug = nullptr) {
    const int G = gridDim.x, c = blockIdx.x;
    const char* wb = (const char*)ws + OFF_WB + (size_t)(layer & 1) * WB_BYTES;
    const char* xb0 = (const char*)ws + OFF_XB0; const char* zb = (const char*)ws + OFF_ZB; const char* mg = (const char*)ws + OFF_MG;
    u.aux = 0; u.ord = i;
    if constexpr (PH == PH_WIN) { const int L = i * G + c; if (L >= 128 * 11) return false; tile_map(L, 128, 11, u.pm, u.pn);
        u.A = xb0 + (size_t)u.pm * 256 * 2048; u.B = wb + W_IN * 2 + (size_t)u.pn * 256 * 2048; return true; }
    if constexpr (PH == PH_SSM1) { const int L = i * G + c; if (L >= 384) return false; const int g = L / 12, rem = L % 12; u.pm = rem / 3; u.pn = rem % 3; u.aux = g;
        u.A = (const char*)ug + ((size_t)g * T_TOK + (size_t)u.pm * 256 * LCH) * 32; u.B = (const char*)ws + OFF_TG + ((size_t)g * 768 + u.pn * 256) * 512 * 2; return true; }
    if constexpr (PH == PH_SSM2) { const int L = i * G + c; if (L >= 256) return false; const int g = L / 8; u.pm = (L % 8) / 2; u.pn = L % 2; u.aux = g;
        u.A = (const char*)ws + OFF_H + ((size_t)u.pm * 256 * 32 + g) * 256 * 2; u.B = (const char*)ws + OFF_MO + ((size_t)g * 512 + u.pn * 256) * 256 * 2; return true; }
    if constexpr (PH == PH_GLU) { const int L = i * G + c; if (L >= 256) return false; tile_map(L, 128, 2, u.pm, u.pn);
        u.A = (const char*)ws + OFF_YI + (size_t)u.pm * 256 * 32; u.B = wb + W_GLU * 2 + (size_t)u.pn * 256 * 512 * 2; return true; }
    if constexpr (PH == PH_MERGE) { const int ui = i / 3, r = i % 3, L = ui * G + c; if (L >= 512) return false; tile_map(L, 128, 4, u.pm, u.pn); u.aux = r; u.ord = ui;
        if constexpr ((SUB & 1) == 0) { u.A = zb + (size_t)u.pm * 256 * ZW * 2; u.B = wb + W_G * 2 + ((size_t)r * 1024 + u.pn * 256) * 1024; }
        else { u.A = zb + ((size_t)u.pm * 256 * ZW + (r == 0 ? 1024 : (r == 1 ? 512 : 2048))) * 2; u.B = wb + W_BR * 2 + ((size_t)r * 1024 + u.pn * 256) * 1024; }
        return true; }
    if constexpr (PH == PH_WOUT) { const int L = i * G + c; if (L >= 512) return false; tile_map(L, 128, 4, u.pm, u.pn);
        u.A = mg + (size_t)u.pm * 256 * 2048; u.B = wb + W_OUT * 2 + (size_t)u.pn * 256 * 2048; return true; }
    if constexpr (PH == PH_FFI) { const int L = i * G + c; if (L >= 128 * 22) return false; tile_map(L, 128, 22, u.pm, u.pn);
        u.A = xb0 + (size_t)u.pm * 256 * 2048; u.B = wb + W_FFI * 2 + (size_t)u.pn * 256 * 2048; return true; }
    if constexpr (PH == PH_FFO) { const int L = i * G + c; if (L >= 512) return false; tile_map(L, 128, 4, u.pm, u.pn); u.aux = 1;
        u.A = zb + (size_t)u.pm * 256 * ZW * 2; u.B = wb + W_FFO * 2 + (size_t)u.pn * 256 * FFH * 2; return true; }
    if constexpr (PH == PH_PLE) { const int L = i * G + c; if (L >= 512) return false; tile_map(L, 128, 4, u.pm, u.pn);
        if constexpr (SUB == 0) { u.A = (const char*)ws + OFF_PB + (size_t)(layer & 1) * PB_BYTES + (size_t)u.pm * 256 * 512; u.B = wb + W_PP * 2 + (size_t)u.pn * 256 * 512; }
        else { u.A = mg + (size_t)u.pm * 256 * 2048; u.B = wb + W_PG * 2 + (size_t)u.pn * 256 * 2048; }
        return true; }
    return false;
}

#define MEMFENCE asm volatile("" ::: "memory")
struct Epi {
    unsigned char* ws; float* x; const float* dskip; int layer; const LAS float* rstab;
    __device__ __forceinline__ void load_rs(const float* ssq, int rbase, int fq, float (&rs)[8]) const {
        f32x4 q[8];
#pragma unroll
        for (int r8 = 0; r8 < 8; ++r8) q[r8] = *(const f32x4*)(ssq + (size_t)(rbase + (r8 >> 2) * 128 + (r8 & 3) * 16) * 16 + fq * 4);
#pragma unroll
        for (int r8 = 0; r8 < 8; ++r8) { float t = (q[r8][0] + q[r8][1]) + (q[r8][2] + q[r8][3]); t += __shfl_xor(t, 16); t += __shfl_xor(t, 32); rs[r8] = rsqrtf(t * (1.0f / 1024.0f) + 1e-6f); }
    }
    __device__ __forceinline__ void get_rs(const Unit& u, int wr, int fr, float (&rs)[8]) const {
#pragma unroll
        for (int r8 = 0; r8 < 8; ++r8) rs[r8] = rstab[u.ord * 256 + (r8 >> 2) * 128 + wr * 64 + (r8 & 3) * 16 + fr];
    }
    template <int KIND> __device__ __forceinline__ void run(f32x4 (&acc)[2][2][4][2], const Unit& u, int tid_in) const {
        int tid = tid_in; asm volatile("" : "+v"(tid));
        const int wid = __builtin_amdgcn_readfirstlane(tid >> 6), lane = tid & 63, wr = wid >> 2, wc = wid & 3, fr = lane & 15, fq = lane >> 4;
        bf16_t* zb = (bf16_t*)(ws + OFF_ZB); bf16_t* yi = (bf16_t*)(ws + OFF_YI); bf16_t* mg = (bf16_t*)(ws + OFF_MG); bf16_t* xb0 = (bf16_t*)(ws + OFF_XB0);
        float* ssq0 = (float*)(ws + OFF_SSQ); float* ssq1 = (float*)(ws + OFF_SSQ + SSQ_BYTES); float* ssq2 = (float*)(ws + OFF_SSQ + 2 * SSQ_BYTES);
        u32x4* scr = (u32x4*)(ws + OFF_TG + ((size_t)blockIdx.x * 2 + (u.ord & 1)) * 131072);
        const int rbase = u.pm * 256 + wr * 64 + fr, cl = wc * 32 + fq * 8;
        if constexpr (KIND == K_WIN) { float rs[8]; get_rs(u, wr, fr, rs);
#pragma unroll
            for (int ai = 0; ai < 2; ++ai)
#pragma unroll
                for (int m = 0; m < 4; ++m) { int row = rbase + ai * 128 + m * 16; asm volatile("" : "+v"(row)); const float r = rs[ai * 4 + m];
                    if (u.pn >= 4 && u.pn < 8) {
                        const f32x4 v0 = (acc[ai][0][m][0] * r) * (acc[ai][1][m][0] * r), v1 = (acc[ai][0][m][1] * r) * (acc[ai][1][m][1] * r);
                        *(u32x4*)(zb + (size_t)row * ZW + 1024 + (u.pn - 4) * 128 + cl) = pack8(v0, v1); }
                    else
#pragma unroll
                    for (int bj = 0; bj < 2; ++bj) { const u32x4 w = pack8(acc[ai][bj][m][0] * r, acc[ai][bj][m][1] * r);
                        if (u.pn < 2) { const int col = u.pn * 256 + bj * 128 + cl; *(u32x4*)((bf16_t*)x + ((size_t)(col >> 4) * T_TOK + row) * 16 + (col & 15)) = w; }
                        else if (u.pn < 10 || bj == 0) *(u32x4*)(zb + (size_t)row * ZW + u.pn * 256 + bj * 128 + cl) = w;
                        else { const int b = row >> 13, s = row & 8191; bf16_t* vp = (bf16_t*)(ws + OFF_VT) + ((size_t)(b * 128 + cl)) * SEQ + s;
                            vp[0 * SEQ] = (bf16_t)(w.x & 0xffff); vp[1 * SEQ] = (bf16_t)(w.x >> 16); vp[2 * SEQ] = (bf16_t)(w.y & 0xffff); vp[3 * SEQ] = (bf16_t)(w.y >> 16);
                            vp[4 * SEQ] = (bf16_t)(w.z & 0xffff); vp[5 * SEQ] = (bf16_t)(w.z >> 16); vp[6 * SEQ] = (bf16_t)(w.w & 0xffff); vp[7 * SEQ] = (bf16_t)(w.w >> 16); } } MEMFENCE; }
        }
        if constexpr (KIND == K_SSM1) { const int g = u.aux;
#pragma unroll
            for (int ai = 0; ai < 2; ++ai)
#pragma unroll
                for (int m = 0; m < 4; ++m) { int R = rbase + ai * 128 + m * 16; asm volatile("" : "+v"(R));
                    if (u.pn < 2) {
#pragma unroll
                        for (int bj = 0; bj < 2; ++bj) { const int t = 16 * u.pn + 8 * bj + 2 * wc + (fq >> 1), p0 = 8 * (fq & 1);
                            *(u32x4*)(yi + ((size_t)g * T_TOK + (size_t)(R * LCH + t)) * 16 + p0) = pack8(acc[ai][bj][m][0], acc[ai][bj][m][1]); }
                    } else { float* sp = (float*)(ws + OFF_S) + ((size_t)(R * 32 + g)) * 128 + cl; *(f32x4*)sp = acc[ai][0][m][0]; *(f32x4*)(sp + 4) = acc[ai][0][m][1]; } }
        }
        if constexpr (KIND == K_SSM2) { const int g = u.aux; const int ch = g * 16 + 8 * (fq & 1); const f32x4 d0 = *(const f32x4*)(dskip + ch), d1 = *(const f32x4*)(dskip + ch + 4);
#pragma unroll
            for (int ai = 0; ai < 2; ++ai)
#pragma unroll
                for (int mh = 0; mh < 2; ++mh) { u32x4 yv[2][2], uv[2][2];
#pragma unroll
                    for (int ml = 0; ml < 2; ++ml) { int R = rbase + ai * 128 + (mh * 2 + ml) * 16; asm volatile("" : "+v"(R));
#pragma unroll
                        for (int bj = 0; bj < 2; ++bj) { const int t = 16 * u.pn + 8 * bj + 2 * wc + (fq >> 1); const size_t tok = (size_t)R * LCH + t;
                            yv[ml][bj] = *(const u32x4*)(yi + ((size_t)g * T_TOK + tok) * 16 + 8 * (fq & 1)); uv[ml][bj] = *(const u32x4*)((const bf16_t*)x + ((size_t)g * T_TOK + tok) * 16 + 8 * (fq & 1)); } }
#pragma unroll
                    for (int ml = 0; ml < 2; ++ml) { const int m = mh * 2 + ml; int R = rbase + ai * 128 + m * 16; asm volatile("" : "+v"(R));
#pragma unroll
                        for (int bj = 0; bj < 2; ++bj) { const int t = 16 * u.pn + 8 * bj + 2 * wc + (fq >> 1); const size_t tok = (size_t)R * LCH + t;
                            f32x4 y0, y1, u0, u1; unpack8(yv[ml][bj], y0, y1); unpack8(uv[ml][bj], u0, u1);
                            y0 = acc[ai][bj][m][0] + y0 + d0 * u0; y1 = acc[ai][bj][m][1] + y1 + d1 * u1;
#pragma unroll
                            for (int j = 0; j < 4; ++j) { y0[j] = gelu_tanh(y0[j]); y1[j] = gelu_tanh(y1[j]); }
                            *(u32x4*)(yi + ((size_t)g * T_TOK + tok) * 16 + 8 * (fq & 1)) = pack8(y0, y1); } }
                    MEMFENCE; }
        }
        if constexpr (KIND == K_GLU) {
#pragma unroll
            for (int ai = 0; ai < 2; ++ai) { u32x4 yv[4][2];
#pragma unroll
                for (int m = 0; m < 4; ++m) { int row = rbase + ai * 128 + m * 16; asm volatile("" : "+v"(row));
#pragma unroll
                    for (int bj = 0; bj < 2; ++bj) { const int col = u.pn * 256 + bj * 128 + cl; yv[m][bj] = *(const u32x4*)(yi + ((size_t)(col >> 4) * T_TOK + row) * 16 + (col & 15)); } }
#pragma unroll
                for (int m = 0; m < 4; ++m) { int row = rbase + ai * 128 + m * 16; asm volatile("" : "+v"(row));
#pragma unroll
                    for (int bj = 0; bj < 2; ++bj) { const int col = u.pn * 256 + bj * 128 + cl; f32x4 y0, y1; unpack8(yv[m][bj], y0, y1);
#pragma unroll
                        for (int j = 0; j < 4; ++j) { y0[j] *= sigmoidf_(acc[ai][bj][m][0][j]); y1[j] *= sigmoidf_(acc[ai][bj][m][1][j]); }
                        *(u32x4*)(zb + (size_t)row * ZW + 1024 + col) = pack8(y0, y1); } }
                MEMFENCE; }
        }
        if constexpr (KIND == K_MG_G) { float rs[8]; get_rs(u, wr, fr, rs);
            u32x4* gst = (u32x4*)((unsigned char*)x + 32 * MiB) + ((size_t)(blockIdx.x * 2 + (u.ord & 1)) * 3 + u.aux) * 4096;
#pragma unroll
            for (int ai = 0; ai < 2; ++ai)
#pragma unroll
                for (int m = 0; m < 4; ++m) { const float r = rs[ai * 4 + m] * (1.0f / GATE_WSCALE); u32x4 w;
#pragma unroll
                    for (int bj = 0; bj < 2; ++bj) { f32x4 a = acc[ai][bj][m][0] * r, b = acc[ai][bj][m][1] * r;
#pragma unroll
                        for (int j = 0; j < 4; ++j) { a[j] = sigmoidf_(a[j]); b[j] = sigmoidf_(b[j]); }
                        if (bj == 0) { w.x = pack4_u8c(a); w.y = pack4_u8c(b); } else { w.z = pack4_u8c(a); w.w = pack4_u8c(b); } }
                    gst[(ai * 4 + m) * 512 + tid] = w; MEMFENCE; }
        }
        if constexpr (KIND == K_PP) {
#pragma unroll
            for (int ai = 0; ai < 2; ++ai)
#pragma unroll
                for (int m = 0; m < 4; ++m)
#pragma unroll
                    for (int bj = 0; bj < 2; ++bj) { scr[((ai * 4 + m) * 2 + bj) * 512 + tid] = pack8(acc[ai][bj][m][0], acc[ai][bj][m][1]); if (bj == 1) MEMFENCE; }
        }
        if constexpr (KIND == K_MG_B) { const int r = u.aux;
            const u32x4* gst = (const u32x4*)((unsigned char*)x + 32 * MiB) + ((size_t)(blockIdx.x * 2 + (u.ord & 1)) * 3) * 4096;
#pragma unroll
            for (int ai = 0; ai < 2; ++ai)
#pragma unroll
                for (int mh = 0; mh < 2; ++mh) { u32x4 qa[2], qb[2];
#pragma unroll
                    for (int ml = 0; ml < 2; ++ml) { const int m = mh * 2 + ml; qa[ml] = gst[(size_t)r * 4096 + (ai * 4 + m) * 512 + tid]; qb[ml] = (r < 2) ? gst[(size_t)(r + 1) * 4096 + (ai * 4 + m) * 512 + tid] : qa[ml]; }
#pragma unroll
                    for (int ml = 0; ml < 2; ++ml) { const int m = mh * 2 + ml; int row = rbase + ai * 128 + m * 16; asm volatile("" : "+v"(row));
#pragma unroll
                        for (int bj = 0; bj < 2; ++bj) {
                            const f32x4 n0 = unpack4_raw(bj == 0 ? qa[ml].x : qa[ml].z), n1 = unpack4_raw(bj == 0 ? qa[ml].y : qa[ml].w);
                            if (r < 2) { const f32x4 d0 = unpack4_raw(bj == 0 ? qb[ml].x : qb[ml].z), d1 = unpack4_raw(bj == 0 ? qb[ml].y : qb[ml].w);
#pragma unroll
                                for (int j = 0; j < 4; ++j) { acc[ai][bj][m][0][j] *= n0[j] * __builtin_amdgcn_rcpf(d0[j]); acc[ai][bj][m][1][j] *= n1[j] * __builtin_amdgcn_rcpf(d1[j]); } }
                            else { const f32x4 o0 = acc[ai][bj][m][0] * n0 * (1.0f / 255.0f), o1 = acc[ai][bj][m][1] * n1 * (1.0f / 255.0f);
                                *(u32x4*)(mg + (size_t)row * 1024 + u.pn * 256 + bj * 128 + cl) = pack8(o0, o1); } } }
                    MEMFENCE; }
        }
        if constexpr (KIND == K_XADD) {
            const bf16_t* xsrc = xb0; bf16_t* xbo = (u.aux ? mg : xb0); float* sso = (u.aux ? ssq2 : ssq1);
            u32x4 xv[2][2][2];
#define XLOAD(gi, bufi) do { _Pragma("unroll") for (int ml = 0; ml < 2; ++ml) { const int m_ = ((gi) & 1) * 2 + ml; int row_ = rbase + ((gi) >> 1) * 128 + m_ * 16; asm volatile("" : "+v"(row_)); \
                _Pragma("unroll") for (int bj = 0; bj < 2; ++bj) xv[bufi][ml][bj] = *(const u32x4*)(xsrc + (size_t)row_ * 1024 + u.pn * 256 + bj * 128 + cl); } } while (0)
            XLOAD(0, 0);
#pragma unroll
            for (int gi = 0; gi < 4; ++gi) { const int ai = gi >> 1, mh = gi & 1, bufi = gi & 1;
                if (gi < 3) XLOAD(gi + 1, (gi + 1) & 1);
#pragma unroll
                for (int ml = 0; ml < 2; ++ml) { const int m = mh * 2 + ml; int row = rbase + ai * 128 + m * 16; asm volatile("" : "+v"(row)); float ss = 0.f;
#pragma unroll
                    for (int bj = 0; bj < 2; ++bj) { const size_t off = (size_t)row * 1024 + u.pn * 256 + bj * 128 + cl; f32x4 x0, x1; unpack8(xv[bufi][ml][bj], x0, x1);
                        const f32x4 o0 = x0 + acc[ai][bj][m][0], o1 = x1 + acc[ai][bj][m][1];
                        *(u32x4*)(xbo + off) = pack8(o0, o1);
                        ss += (o0[0] * o0[0] + o0[1] * o0[1]) + (o0[2] * o0[2] + o0[3] * o0[3]) + (o1[0] * o1[0] + o1[1] * o1[1]) + (o1[2] * o1[2] + o1[3] * o1[3]); }
                    ss += __shfl_xor(ss, 16); ss += __shfl_xor(ss, 32);
                    if (fq == 0) sso[((size_t)u.pn * T_TOK + row) * 4 + wc] = ss; }
                MEMFENCE; }
#undef XLOAD
        }
        if constexpr (KIND == K_PLE) {
            const bf16_t* xsrc = mg; float rs[8]; get_rs(u, wr, fr, rs);
#pragma unroll
            for (int ai = 0; ai < 2; ++ai)
#pragma unroll
                for (int mh = 0; mh < 2; ++mh) { u32x4 xv[2][2], pv[2][2];
#pragma unroll
                    for (int ml = 0; ml < 2; ++ml) { const int m = mh * 2 + ml; int row = rbase + ai * 128 + m * 16; asm volatile("" : "+v"(row));
#pragma unroll
                        for (int bj = 0; bj < 2; ++bj) { xv[ml][bj] = *(const u32x4*)(xsrc + (size_t)row * 1024 + u.pn * 256 + bj * 128 + cl); pv[ml][bj] = scr[((ai * 4 + m) * 2 + bj) * 512 + tid]; } }
#pragma unroll
                    for (int ml = 0; ml < 2; ++ml) { const int m = mh * 2 + ml; int row = rbase + ai * 128 + m * 16; asm volatile("" : "+v"(row)); float ss = 0.f; const float r = rs[ai * 4 + m];
#pragma unroll
                        for (int bj = 0; bj < 2; ++bj) { const size_t off = (size_t)row * 1024 + u.pn * 256 + bj * 128 + cl; f32x4 a = acc[ai][bj][m][0], b = acc[ai][bj][m][1], p0, p1, x0, x1;
                            unpack8(pv[ml][bj], p0, p1); unpack8(xv[ml][bj], x0, x1);
#pragma unroll
                            for (int j = 0; j < 4; ++j) { a[j] = sigmoidf_(a[j] * r) * p0[j]; b[j] = sigmoidf_(b[j] * r) * p1[j]; }
                            const f32x4 o0 = x0 + a, o1 = x1 + b;
                            *(u32x4*)(xb0 + off) = pack8(o0, o1);
                            { u32x2 w8; w8.x = pack4_fp8(o0[0], o0[1], o0[2], o0[3]); w8.y = pack4_fp8(o1[0], o1[1], o1[2], o1[3]); *(u32x2*)((unsigned char*)zb + (size_t)row * (ZW * 2) + u.pn * 256 + bj * 128 + cl) = w8; }
                            ss += (o0[0] * o0[0] + o0[1] * o0[1]) + (o0[2] * o0[2] + o0[3] * o0[3]) + (o1[0] * o1[0] + o1[1] * o1[1]) + (o1[2] * o1[2] + o1[3] * o1[3]); }
                        ss += __shfl_xor(ss, 16); ss += __shfl_xor(ss, 32);
                        if (fq == 0) ssq0[((size_t)u.pn * T_TOK + row) * 4 + wc] = ss; }
                    MEMFENCE; }
        }
        if constexpr (KIND == K_FFI) { bf16_t* act = zb; float rs[8]; get_rs(u, wr, fr, rs);
#pragma unroll
            for (int ai = 0; ai < 2; ++ai)
#pragma unroll
                for (int m = 0; m < 4; ++m) { int row = rbase + ai * 128 + m * 16; asm volatile("" : "+v"(row)); const float r = rs[ai * 4 + m]; f32x4 o[2];
#pragma unroll
                    for (int n = 0; n < 2; ++n) { const f32x4 g = acc[ai][0][m][n] * r, v = acc[ai][1][m][n] * r;
#pragma unroll
                        for (int j = 0; j < 4; ++j) o[n][j] = g[j] * sigmoidf_(g[j]) * v[j]; }
                    *(u32x4*)(act + (size_t)row * ZW + u.pn * 128 + cl) = pack8(o[0], o[1]); MEMFENCE; }
        }
    }
};


template <int PH, int SUB> __device__ __forceinline__ void rs_fill(LAS unsigned char* lds, const Epi& E) {
    constexpr int kind = shape_of<PH, SUB>().kind;
    if constexpr ((kind == K_WIN || kind == K_MG_G || kind == K_FFI || kind == K_PLE) && !(PH == PH_MERGE && SUB != 0)) {
        const int tidx = ltid();
        const float* ssq = (const float*)(E.ws + OFF_SSQ + (kind == K_FFI ? SSQ_BYTES : (kind == K_PLE ? 2 * SSQ_BYTES : 0)));
        LAS float* tab = (LAS float*)(lds + STAGE_BYTES + 16);
        for (int i = 0; i < 12; ++i) { Unit u; if (!sched_next<PH, SUB>(E.ws, E.layer, i, u)) break;
            const int r = tidx >> 1, hf = tidx & 1; const size_t row = (size_t)(u.pm * 256 + r); f32x4 a, b;
            { unsigned* pa = (unsigned*)(ssq + ((size_t)(2 * hf) * T_TOK + row) * 4); unsigned* pb = (unsigned*)(ssq + ((size_t)(2 * hf + 1) * T_TOK + row) * 4);
#pragma unroll
              for (int j = 0; j < 4; ++j) { a[j] = __uint_as_float(__hip_atomic_load(pa + j, __ATOMIC_RELAXED, __HIP_MEMORY_SCOPE_AGENT)); b[j] = __uint_as_float(__hip_atomic_load(pb + j, __ATOMIC_RELAXED, __HIP_MEMORY_SCOPE_AGENT)); } }
            float t = ((a[0] + a[1]) + (a[2] + a[3])) + ((b[0] + b[1]) + (b[2] + b[3])); t += __shfl_xor(t, 1);
            if (hf == 0) tab[u.ord * 256 + r] = rsqrtf(t * (1.0f / 1024.0f) + 1e-6f); }
        __syncthreads();
    }
}
template <int PH, int SUB = 0> __device__ __forceinline__ void gemm_phase(LAS unsigned char* lds, const Epi& E) {
    rs_fill<PH, SUB>(lds, E);
    int tid = threadIdx.x; asm volatile("" : "+v"(tid));
    const int wid = __builtin_amdgcn_readfirstlane(tid >> 6), lane = tid & 63, wr = wid >> 2, wc = wid & 3, fr = lane & 15, fq = lane >> 4;
    int R0, C0; stage_rc(tid * 16, R0, C0);
    const unsigned Rb0 = (unsigned)((R0 & ~31) + perm32(R0 & 31)), c1 = (unsigned)(C0 >> 4), c0b = (unsigned)((C0 & 15) * 2);
    const unsigned ldsw = (unsigned)wid * 1024u;
    const int aoff = lds_byte(wr * 64 + fr, fq * 8), boff = lds_byte(wc * 32 + fr, fq * 8);
    constexpr Shape cs = shape_of<PH, SUB>(); constexpr bool FP8 = (PH == PH_MERGE && (SUB & 1) == 0);
    const unsigned cA0 = (unsigned)R0 * cs.rsA + c1 * cs.ssA + c0b, cB0 = (Rb0 * cs.Kb + (unsigned)C0) * 2u;
    constexpr size_t chA = (size_t)128 * cs.rsA, ckA = (size_t)4 * cs.ssA, chB = (size_t)256 * cs.Kb, qA = (size_t)64 * cs.rsA, qB = (size_t)128 * cs.Kb, kB = 128;
    constexpr int nt = cs.nt;
#define G_SA(b, h) (((b) * 2 + (h)) * HTB)
#define G_SB(b, h) ((4 + (b) * 2 + (h)) * HTB)
#define G_STAGE(bufoff, gbase, o0, h64) do { \
        __builtin_amdgcn_global_load_lds((const unsigned*)((const char*)(gbase) + (o0)), (LAS unsigned*)(lds + (bufoff) + ldsw), 16, 0, 0); \
        __builtin_amdgcn_global_load_lds((const unsigned*)((const char*)(gbase) + (h64) + (o0)), (LAS unsigned*)(lds + (bufoff) + ldsw + 8192), 16, 0, 0); } while (0)
#define G_LDA(dst, b, h) do { _Pragma("unroll") for (int m = 0; m < 4; ++m) _Pragma("unroll") for (int k = 0; k < 2; ++k) dst[m][k] = *(const LAS bf16x8*)(lds + G_SA(b, h) + aoff + m * 2048 + k * 1024); } while (0)
#define G_LDB(dst, b, h) do { _Pragma("unroll") for (int n = 0; n < 2; ++n) _Pragma("unroll") for (int k = 0; k < 2; ++k) dst[n][k] = *(const LAS bf16x8*)(lds + G_SB(b, h) + boff + n * 2048 + k * 1024); } while (0)
#define G_MMA(ai, bj, At, Bt) do { __builtin_amdgcn_s_setprio(3); _Pragma("unroll") for (int m = 0; m < 4; ++m) _Pragma("unroll") for (int n = 0; n < 2; ++n) _Pragma("unroll") for (int k = 0; k < 2; ++k) { \
        if constexpr (FP8) acc[ai][bj][m][n] = mma_fp8(Bt[n][k], At[m][k], acc[ai][bj][m][n]); \
        else acc[ai][bj][m][n] = __builtin_amdgcn_mfma_f32_16x16x32_bf16(Bt[n][k], At[m][k], acc[ai][bj][m][n], 0, 0, 0); } __builtin_amdgcn_s_setprio(0); } while (0)
#define G_WAIT_V(n) asm volatile("s_waitcnt vmcnt(" #n ")" ::: "memory")
#define G_WAIT_L(n) asm volatile("s_waitcnt lgkmcnt(" #n ")" ::: "memory")
#define G_BAR __builtin_amdgcn_s_barrier()
#define G_SCHED __builtin_amdgcn_sched_barrier(0)
    Unit cur, nxt; int ui = 0;
    if (!sched_next<PH, SUB>(E.ws, E.layer, 0, cur, E.x)) return;
    f32x4 acc[2][2][4][2];
#pragma unroll
    for (int a = 0; a < 2; ++a)
#pragma unroll
        for (int b = 0; b < 2; ++b)
#pragma unroll
            for (int m = 0; m < 4; ++m)
#pragma unroll
                for (int n = 0; n < 2; ++n) acc[a][b][m][n] = (f32x4){0.f, 0.f, 0.f, 0.f};
    bf16x8 At[4][2], B0[2][2], B1[2][2];
    const char* cA = cur.A; const char* cB = cur.B;
    G_STAGE(G_SB(0, 0), cB, cB0, qB); G_STAGE(G_SA(0, 0), cA, cA0, qA); G_STAGE(G_SB(0, 1), cB + chB, cB0, qB); G_STAGE(G_SA(0, 1), cA + chA, cA0, qA);
    if (wr == 1) G_BAR;
    G_WAIT_V(4); G_BAR;
    G_STAGE(G_SB(1, 0), cB + kB, cB0, qB); G_STAGE(G_SA(1, 0), cA + ckA, cA0, qA); G_STAGE(G_SB(1, 1), cB + chB + kB, cB0, qB);
    G_WAIT_V(6); G_BAR;
    for (;;) {
        const bool has_next = sched_next<PH, SUB>(E.ws, E.layer, ui + 1, nxt, E.x);
        if (!has_next) nxt = cur;
        const char* nA = nxt.A; const char* nB = nxt.B;
#pragma unroll 1
        for (int t = 0; t < nt; t += 2) {
            const bool last = (t == nt - 2);
            const char* a1 = cA + (size_t)(t + 1) * ckA;
            const char* a2 = last ? nA : cA + (size_t)(t + 2) * ckA; const char* b2 = last ? nB : cB + (size_t)(t + 2) * kB;
            const char* a3 = a2 + ckA; const char* b3 = b2 + kB;
            G_LDB(B0, 0, 0); G_SCHED; G_LDA(At, 0, 0); G_STAGE(G_SA(1, 1), a1 + chA, cA0, qA);
            G_WAIT_L(8); G_BAR; G_WAIT_L(0); G_MMA(0, 0, At, B0); G_BAR; G_SCHED;
            G_LDB(B1, 0, 1); G_STAGE(G_SB(0, 0), b2, cB0, qB);
            G_BAR; G_WAIT_L(0); G_MMA(0, 1, At, B1); G_BAR;
            G_LDA(At, 0, 1); G_STAGE(G_SA(0, 0), a2, cA0, qA);
            G_BAR; G_WAIT_L(0); G_MMA(1, 0, At, B0); G_BAR; G_SCHED;
            G_STAGE(G_SB(0, 1), b2 + chB, cB0, qB);
            G_WAIT_V(6); G_BAR; G_MMA(1, 1, At, B1); G_BAR;
            G_LDB(B0, 1, 0); G_SCHED; G_LDA(At, 1, 0); G_STAGE(G_SA(0, 1), a2 + chA, cA0, qA);
            G_WAIT_L(8); G_BAR; G_WAIT_L(0); G_MMA(0, 0, At, B0); G_BAR; G_SCHED;
            G_LDB(B1, 1, 1); G_STAGE(G_SB(1, 0), b3, cB0, qB);
            G_BAR; G_WAIT_L(0); G_MMA(0, 1, At, B1); G_BAR;
            G_LDA(At, 1, 1); G_STAGE(G_SA(1, 0), a3, cA0, qA);
            G_BAR; G_WAIT_L(0); G_MMA(1, 0, At, B0); G_BAR; G_SCHED;
            G_STAGE(G_SB(1, 1), b3 + chB, cB0, qB);
            G_WAIT_V(6); G_BAR; G_MMA(1, 1, At, B1); G_BAR;
        }
        E.template run<cs.kind>(acc, cur, tid);
        if (!has_next) break;
        if (!(cs.kind == K_MG_B && cur.aux < 2))
#pragma unroll
        for (int a = 0; a < 2; ++a)
#pragma unroll
            for (int b = 0; b < 2; ++b)
#pragma unroll
                for (int m = 0; m < 4; ++m)
#pragma unroll
                    for (int n = 0; n < 2; ++n) acc[a][b][m][n] = (f32x4){0.f, 0.f, 0.f, 0.f};
        cur = nxt; cA = nA; cB = nB; ++ui;
    }
    G_WAIT_V(0);
    if (wr == 0) G_BAR;
    G_BAR;
#undef G_SA
#undef G_SB
#undef G_STAGE
#undef G_LDA
#undef G_LDB
#undef G_MMA
#undef G_WAIT_V
#undef G_WAIT_L
#undef G_BAR
#undef G_SCHED
}

__device__ __forceinline__ void convert_job(unsigned char* smem, const float* src, int ld, int col0, int mapkind, int N, int K, const float* scale, bf16_t* dst, int vb, int vG) {
    const int tidx = ltid();
    bf16_t* tile = (bf16_t*)smem;
    const int w = tidx >> 6, lane = tidx & 63;
    const int tn = N / 64, tk = K / 256, ntile = tn * tk;
    for (int t = vb; t < ntile; t += vG) {
        const int n0 = (t % tn) * 64, k0 = (t / tn) * 256;
        const int np = n0 + lane; int sc;
        if (mapkind == 0) sc = col0 + np;
        else if (mapkind == 2) { if (np >= 1024 && np < 2048) { const int pq = (np - 1024) >> 8, c = np & 255; sc = (c < 128) ? (1024 + pq * 128 + c) : (1536 + pq * 128 + (c - 128)); } else sc = np; }
        else { const int pn = np >> 8, c = np & 255; sc = (c < 128) ? (pn * 128 + c) : (FFH + pn * 128 + (c - 128)); }
        float v[32];
#pragma unroll
        for (int rr = 0; rr < 32; ++rr) v[rr] = src[(size_t)(k0 + w * 32 + rr) * ld + sc];
        if (scale) {
#pragma unroll
            for (int rr = 0; rr < 32; ++rr) v[rr] *= scale[k0 + w * 32 + rr]; }
#pragma unroll
        for (int rr = 0; rr < 32; rr += 2) *(unsigned*)(tile + lane * 258 + w * 32 + rr) = cvt_pk_bf16(v[rr], v[rr + 1]);
        __syncthreads();
#pragma unroll
        for (int i = 0; i < 4; ++i) { const int idx = tidx + i * 512, nn = idx >> 5, k8 = idx & 31; const unsigned* tp = (const unsigned*)(tile + nn * 258 + k8 * 8); u32x4 o; o.x = tp[0]; o.y = tp[1]; o.z = tp[2]; o.w = tp[3];
            *(u32x4*)(dst + (size_t)(n0 + nn) * K + k0 + k8 * 8) = o; }
        __syncthreads();
    }
}
__device__ __forceinline__ void convert_layer(unsigned char* smem, const Params& P, int layer, int skip) {
    const int tidx = ltid();
    if ((int)blockIdx.x < skip) return;
    const int vb = blockIdx.x - skip, vG = gridDim.x - skip;
    bf16_t* wb = (bf16_t*)(P.ws + OFF_WB + (size_t)(layer & 1) * WB_BYTES);
    convert_job(smem, P.w_in + (size_t)layer * DM * INW, INW, 0, 2, ZW, DM, P.norm_mix + layer * DM, wb + W_IN, vb, vG);
    { const float* src = P.w_in + (size_t)layer * DM * INW + ZW; const float* gain = P.norm_mix + layer * DM; unsigned char* dst = (unsigned char*)(wb + W_G);
      for (size_t idx = (size_t)vb * 512 + tidx; idx < (size_t)3072 * 128; idx += (size_t)vG * 512) { const int n = (int)(idx % 3072), k8 = (int)(idx / 3072); float v[8];
#pragma unroll
          for (int j = 0; j < 8; ++j) v[j] = src[(size_t)(k8 * 8 + j) * INW + n] * gain[k8 * 8 + j] * GATE_WSCALE;
          u32x2 w8; w8.x = pack4_fp8(v[0], v[1], v[2], v[3]); w8.y = pack4_fp8(v[4], v[5], v[6], v[7]); *(u32x2*)(dst + (size_t)n * 1024 + k8 * 8) = w8; } }
    convert_job(smem, P.w_glu + (size_t)layer * 512 * 512, 512, 0, 0, 512, 512, nullptr, wb + W_GLU, vb, vG);
    for (int r = 0; r < 3; ++r) convert_job(smem, P.w_branch + ((size_t)layer * 3 + r) * 512 * 1024, 1024, 0, 0, 1024, 512, nullptr, wb + W_BR + (size_t)r * 1024 * 512, vb, vG);
    convert_job(smem, P.w_out + (size_t)layer * DM * DM, DM, 0, 0, DM, DM, nullptr, wb + W_OUT, vb, vG);
    convert_job(smem, P.w_ffn_in + (size_t)layer * DM * 2 * FFH, 2 * FFH, 0, 1, 2 * FFH, DM, P.norm_ffn + layer * DM, wb + W_FFI, vb, vG);
    convert_job(smem, P.w_ffn_out + (size_t)layer * FFH * DM, DM, 0, 0, DM, FFH, nullptr, wb + W_FFO, vb, vG);
    convert_job(smem, P.w_ple_gate + (size_t)layer * DM * DM, DM, 0, 0, DM, DM, P.norm_ple + layer * DM, wb + W_PG, vb, vG);
    convert_job(smem, P.w_ple_proj + (size_t)layer * 256 * DM, DM, 0, 0, DM, 256, nullptr, wb + W_PP, vb, vG);
    const f32x4* ps = (const f32x4*)(P.p + (size_t)layer * T_TOK * 256); u32x4* pd = (u32x4*)(P.ws + OFF_PB + (size_t)(layer & 1) * PB_BYTES);
    for (size_t i = (size_t)vb * 512 + tidx; i < (size_t)T_TOK * 256 / 8; i += (size_t)vG * 512) pd[i] = pack8(ps[2 * i], ps[2 * i + 1]);
}

__device__ __forceinline__ void a_pow(float lr, float li, float dt, int tau, float& re, float& im) {
    const float mag = __expf(lr * dt * (float)tau);
    double rev = (double)li * (double)dt * (double)tau * 0.15915494309189535; rev -= rint(rev);
    const double q = rint(rev * 4.0), th = (rev * 4.0 - q) * 1.5707963267948966, t2 = th * th;
    const double sn = th * (1.0 + t2 * (-1.0 / 6 + t2 * (1.0 / 120 + t2 * (-1.0 / 5040 + t2 * (1.0 / 362880 + t2 * (-1.0 / 39916800))))));
    const double cs = 1.0 + t2 * (-0.5 + t2 * (1.0 / 24 + t2 * (-1.0 / 720 + t2 * (1.0 / 40320 + t2 * (-1.0 / 3628800 + t2 * (1.0 / 479001600))))));
    const int qi = ((int)q) & 3; double c, s;
    if (qi == 0) { c = cs; s = sn; } else if (qi == 1) { c = -sn; s = cs; } else if (qi == 2) { c = -cs; s = -sn; } else { c = sn; s = -cs; }
    re = mag * (float)c; im = mag * (float)s;
}
__device__ __forceinline__ void ssm_group_tables(const Params& P, int layer, int g, int tau0, int ntau, float2* AT, float2* BB, float2* CC) {
    const int tidx = ltid();
    const int tid = tidx; const size_t gl = (size_t)layer * 32 + g;
    const float dt = __expf(P.log_dt[gl]);
    for (int i = tid; i < ntau * 64; i += 512) { const int tau = tau0 + i / 64, n = i % 64; float re, im; a_pow(P.lam_re[gl * 64 + n], P.lam_im[gl * 64 + n], dt, tau, re, im); AT[i] = make_float2(re, im); }
    for (int i = tid; i < 1024; i += 512) { const int n = i >> 4;
        const float lr = P.lam_re[gl * 64 + n], li = P.lam_im[gl * 64 + n]; float ar, ai; a_pow(lr, li, dt, 1, ar, ai);
        const float den = lr * lr + li * li, nr = ar - 1.0f, cr = (nr * lr + ai * li) / den, ci = (ai * lr - nr * li) / den;
        const float br = P.b_re[gl * 1024 + i], bi = P.b_im[gl * 1024 + i];
        BB[i] = make_float2(cr * br - ci * bi, cr * bi + ci * br);
        CC[i] = make_float2(P.c_re[gl * 1024 + i], P.c_im[gl * 1024 + i]); }
}
__device__ __forceinline__ void ssm_ktable(unsigned char* smem, const Params& P) {
    const int tidx = ltid();
    float2* AT = (float2*)smem; float2* BB = AT + 4 * 64; float2* CC = BB + 1024;
    float* Kt = (float*)(P.ws + OFF_KT);
    for (int job = blockIdx.x; job < N_LAYERS * 256; job += gridDim.x) { const int layer = job >> 8, g = (job >> 3) & 31, sub = job & 7;
        __syncthreads(); ssm_group_tables(P, layer, g, 4 * sub, 4, AT, BB, CC); __syncthreads();
        for (int i = tidx; i < 1024; i += 512) { const int tl = i >> 8, p = (i >> 4) & 15, q = i & 15; float s = 0.f;
            for (int n = 0; n < 64; ++n) { const float2 a = AT[tl * 64 + n], b = BB[n * 16 + q], c = CC[p * 64 + n]; const float wr_ = a.x * b.x - a.y * b.y, wi_ = a.x * b.y + a.y * b.x; s += c.x * wr_ - c.y * wi_; }
            Kt[((size_t)(layer * 32 + g) * 32 + 4 * sub + tl) * 256 + (i & 255)] = s; } }
}
__device__ __forceinline__ void ssm_group_tables_all(const Params& P) {
    for (int job = blockIdx.x; job < N_LAYERS * 32; job += gridDim.x) { float2* base = (float2*)(P.ws + OFF_GT) + (size_t)job * 4160;
        ssm_group_tables(P, job >> 5, job & 31, 0, 33, base, base + 33 * 64, base + 33 * 64 + 1024); }
}
__device__ __forceinline__ void ssm_tables(unsigned char* smem, const Params& P, int layer, int job0, int job1, int jstep) {
    const int tidx = ltid();
    float2* AT = (float2*)smem; float2* BB = AT + 33 * 64; float2* CC = BB + 1024;
    const float* Kt = (const float*)(P.ws + OFF_KT) + (size_t)layer * 32 * 8192; const int tid = tidx;
    for (int job = job0; job < job1; job += jstep) { const int g = job >> 3, sub = job & 7;
        __syncthreads(); { const float2* src = (const float2*)(P.ws + OFF_GT) + (size_t)(layer * 32 + g) * 4160; for (int i = tid; i < 4160; i += 512) AT[i] = src[i]; } __syncthreads();
        bf16_t* Tg = (bf16_t*)(P.ws + OFF_TG) + (size_t)g * 768 * 512; bf16_t* Mo = (bf16_t*)(P.ws + OFF_MO) + (size_t)g * 512 * 256; const float* Kg = Kt + (size_t)g * 8192;
        for (int i = tid; i < 64 * 64; i += 512) { const int rl = i >> 6, pc = i & 63, t = 4 * sub + (rl >> 4), p = rl & 15, s = pc >> 1, q0 = (pc & 1) * 8; u32x4 w = {0u, 0u, 0u, 0u};
            if (t >= s) { const float* kp = Kg + (size_t)(t - s) * 256 + p * 16 + q0; w = pack8(*(const f32x4*)kp, *(const f32x4*)(kp + 4)); }
            *(u32x4*)(Tg + (size_t)(t * 16 + p) * 512 + pc * 8) = w; }
        for (int i = tid; i < 16 * 64; i += 512) { const int np = 16 * sub + (i >> 6), pc = i & 63, n = np & 63, s = pc >> 1, q0 = (pc & 1) * 8; const float2 a = AT[(LCH - 1 - s) * 64 + n]; f32x4 v0, v1;
#pragma unroll
            for (int j = 0; j < 8; ++j) { const float2 b = BB[n * 16 + q0 + j]; const float val = (np < 64) ? (a.x * b.x - a.y * b.y) : (a.x * b.y + a.y * b.x); if (j < 4) v0[j] = val; else v1[j - 4] = val; }
            *(u32x4*)(Tg + (size_t)(512 + np) * 512 + pc * 8) = pack8(v0, v1);
            *(u32x4*)(Tg + (size_t)(640 + np) * 512 + pc * 8) = (u32x4){0u, 0u, 0u, 0u}; }
        for (int i = tid; i < 64 * 32; i += 512) { const int rl = i >> 5, pc = i & 31, t = 4 * sub + (rl >> 4), p = rl & 15; u32x4 w = {0u, 0u, 0u, 0u};
            if (pc < 16) { const int n0 = (pc & 7) * 8; f32x4 v0, v1;
#pragma unroll
                for (int j = 0; j < 8; ++j) { const float2 a = AT[(t + 1) * 64 + n0 + j], c = CC[p * 64 + n0 + j]; const float val = (pc < 8) ? (c.x * a.x - c.y * a.y) : -(c.x * a.y + c.y * a.x); if (j < 4) v0[j] = val; else v1[j - 4] = val; }
                w = pack8(v0, v1); }
            *(u32x4*)(Mo + (size_t)(t * 16 + p) * 256 + pc * 8) = w; }
        if (sub == 0 && tid < 64) ((float2*)(P.ws + OFF_AL))[g * 64 + tid] = AT[LCH * 64 + tid];
    }
}
__device__ __forceinline__ void ssm_scan(const Params& P) {
    const int tidx = ltid();
    const int gt = blockIdx.x * 512 + tidx; if (gt >= 8192) return;
    const int b = gt >> 11, g = (gt >> 6) & 31, n = gt & 63;
    float2 a; { unsigned* ap = (unsigned*)(P.ws + OFF_AL) + (g * 64 + n) * 2; a.x = __uint_as_float(__hip_atomic_load(ap, __ATOMIC_RELAXED, __HIP_MEMORY_SCOPE_AGENT)); a.y = __uint_as_float(__hip_atomic_load(ap + 1, __ATOMIC_RELAXED, __HIP_MEMORY_SCOPE_AGENT)); }
    const float* S = (const float*)(P.ws + OFF_S); bf16_t* H = (bf16_t*)(P.ws + OFF_H);
    float hr = 0.f, hi = 0.f;
    for (int c0 = 0; c0 < 256; c0 += 32) { float sr[32], si[32];
#pragma unroll
        for (int j = 0; j < 32; ++j) { const size_t o = ((size_t)(b * 256 + c0 + j) * 32 + g) * 128 + n; sr[j] = S[o]; si[j] = S[o + 64]; }
#pragma unroll
        for (int j = 0; j < 32; ++j) { bf16_t* hp = H + ((size_t)(b * 256 + c0 + j) * 32 + g) * 256 + n; const unsigned w = cvt_pk_bf16(hr, hi);
            hp[0] = (bf16_t)(w & 0xffff); hp[64] = (bf16_t)(w >> 16); hp[128] = 0; hp[192] = 0;
            const float nr = a.x * hr - a.y * hi + sr[j], ni = a.x * hi + a.y * hr + si[j]; hr = nr; hi = ni; } }
}

__device__ __forceinline__ void conv_phase(const Params& P, int layer) {
    const int tidx = ltid();
    bf16_t* zb = (bf16_t*)(P.ws + OFF_ZB); const float* cw = P.conv_w + (size_t)layer * 3 * 512;
    const int c8 = (tidx & 63) * 8;
    f32x4 w[3][2];
#pragma unroll
    for (int d = 0; d < 3; ++d) { w[d][0] = *(const f32x4*)(cw + d * 512 + c8); w[d][1] = *(const f32x4*)(cw + d * 512 + c8 + 4); }
    for (int run = blockIdx.x * 8 + (tidx >> 6); run < T_TOK / 16; run += gridDim.x * 8) {
        const size_t t0 = (size_t)run * 16; const int s0 = (int)(t0 & 8191);
        bf16_t* base = zb + t0 * ZW + c8;
        f32x4 v1[2] = {{0.f, 0.f, 0.f, 0.f}, {0.f, 0.f, 0.f, 0.f}}, v2[2] = {{0.f, 0.f, 0.f, 0.f}, {0.f, 0.f, 0.f, 0.f}};
        if (s0 > 0) { unpack8(*(const u32x4*)(base - (size_t)ZW + 1024), v1[0], v1[1]); unpack8(*(const u32x4*)(base - (size_t)2 * ZW + 1024), v2[0], v2[1]); }
#pragma unroll
        for (int q = 0; q < 4; ++q) { u32x4 cbv[4], vv[4];
#pragma unroll
            for (int j = 0; j < 4; ++j) { bf16_t* bp = base + (size_t)(q * 4 + j) * ZW; cbv[j] = *(const u32x4*)(bp + 512); vv[j] = *(const u32x4*)(bp + 1024); }
#pragma unroll
            for (int j = 0; j < 4; ++j) { f32x4 v00, v01, g0, g1; unpack8(vv[j], v00, v01); unpack8(cbv[j], g0, g1);
                const f32x4 y0 = g0 * (w[0][0] * v2[0] + w[1][0] * v1[0] + w[2][0] * v00), y1 = g1 * (w[0][1] * v2[1] + w[1][1] * v1[1] + w[2][1] * v01);
                *(u32x4*)(base + (size_t)(q * 4 + j) * ZW + 512) = pack8(y0, y1);
                v2[0] = v1[0]; v2[1] = v1[1]; v1[0] = v00; v1[1] = v01; } }
    }
}

__device__ __forceinline__ void attn_phase(unsigned char* smem, const Params& P, int layer) {
    const int tidx = ltid();
    bf16_t* Kl = (bf16_t*)smem;
    bf16_t* Vl = (bf16_t*)(smem + 256 * 72 * 2);
    float* Bl = (float*)(smem + 256 * 72 * 2 + 64 * 264 * 2);
    bf16_t* zb = (bf16_t*)(P.ws + OFF_ZB); const bf16_t* vT = (const bf16_t*)(P.ws + OFF_VT); const float* biasd = (const float*)(P.ws + OFF_BIAS);
    const int tid = tidx, w = tid >> 6, lane = tid & 63, ql = lane & 15, q4 = lane >> 4;
    for (int item = blockIdx.x; item < 512; item += gridDim.x) {
        const int b = item >> 7, blk = (item & 127) >> 1, kvh = item & 1, s0 = blk * 128;
        __syncthreads();
        for (int pc = tid; pc < 2048; pc += 512) { const int key = pc >> 3, d8 = pc & 7, s = s0 - 128 + key; u32x4 v = {0u, 0u, 0u, 0u};
            if (s >= 0) v = *(const u32x4*)(zb + ((size_t)(b * SEQ + s)) * ZW + 2560 + kvh * 64 + d8 * 8);
            *(u32x4*)(Kl + key * 72 + d8 * 8) = v; }
        for (int pc = tid; pc < 2048; pc += 512) { const int d = pc >> 5, k8 = pc & 31, s = s0 - 128 + k8 * 8; u32x4 v = {0u, 0u, 0u, 0u};
            if (s >= 0) v = *(const u32x4*)(vT + ((size_t)(b * 128 + kvh * 64 + d)) * SEQ + s);
            *(u32x4*)(Vl + d * 264 + k8 * 8) = v; }
        Bl[tid] = biasd[(kvh * 4 + (tid >> 7)) * 128 + (tid & 127)];
        __syncthreads();
        const bf16_t* qbase = zb + (size_t)(b * SEQ + s0 + 16 * w + ql) * ZW + 2048 + kvh * 256 + q4 * 8;
        bf16x8 Qn0 = *(const bf16x8*)(qbase), Qn1 = *(const bf16x8*)(qbase + 32);
        for (int g = 0; g < 4; ++g) { const int h = kvh * 4 + g;
            const bf16x8 Q0 = Qn0, Q1 = Qn1;
            if (g < 3) { Qn0 = *(const bf16x8*)(qbase + (g + 1) * 64); Qn1 = *(const bf16x8*)(qbase + (g + 1) * 64 + 32); }
            const float sink = P.sinks[layer * 8 + h];
            f32x4 sc[10]; float mx = sink;
#pragma unroll
            for (int tt = 0; tt < 10; ++tt) { const int tl = w + tt, tc = tl < 15 ? tl : 15;
                const bf16x8 K0 = *(const bf16x8*)(Kl + (16 * tc + ql) * 72 + q4 * 8), K1 = *(const bf16x8*)(Kl + (16 * tc + ql) * 72 + 32 + q4 * 8);
                f32x4 a = {0.f, 0.f, 0.f, 0.f}; a = __builtin_amdgcn_mfma_f32_16x16x32_bf16(K0, Q0, a, 0, 0, 0); a = __builtin_amdgcn_mfma_f32_16x16x32_bf16(K1, Q1, a, 0, 0, 0);
#pragma unroll
                for (int j = 0; j < 4; ++j) { const int dist = ql + 128 - 16 * tt - 4 * q4 - j, kj = 16 * tl + 4 * q4 + j;
                    const bool valid = (dist >= 0) && (dist < 128) && (tl < 16) && (blk > 0 || kj >= 128);
                    const float sv = valid ? (a[j] * 0.125f + Bl[g * 128 + (dist & 127)]) : -INFINITY; a[j] = sv; mx = fmaxf(mx, sv); }
                sc[tt] = a; }
            mx = fmaxf(mx, __shfl_xor(mx, 16)); mx = fmaxf(mx, __shfl_xor(mx, 32));
            float l = 0.f;
#pragma unroll
            for (int tt = 0; tt < 10; ++tt)
#pragma unroll
                for (int j = 0; j < 4; ++j) { const float pv = __expf(sc[tt][j] - mx); sc[tt][j] = pv; l += pv; }
            l += __shfl_xor(l, 16); l += __shfl_xor(l, 32); l += __expf(sink - mx);
            const float linv = 1.0f / l;
            f32x4 o[4];
#pragma unroll
            for (int dt = 0; dt < 4; ++dt) o[dt] = (f32x4){0.f, 0.f, 0.f, 0.f};
#pragma unroll
            for (int pp = 0; pp < 5; ++pp) { const int tA = w + 2 * pp, tB = tA + 1, cA_ = tA < 15 ? tA : 15, cB_ = tB < 15 ? tB : 15;
                u32x4 pw; pw.x = cvt_pk_bf16(sc[2 * pp][0], sc[2 * pp][1]); pw.y = cvt_pk_bf16(sc[2 * pp][2], sc[2 * pp][3]); pw.z = cvt_pk_bf16(sc[2 * pp + 1][0], sc[2 * pp + 1][1]); pw.w = cvt_pk_bf16(sc[2 * pp + 1][2], sc[2 * pp + 1][3]);
                bf16x8 Pf; __builtin_memcpy(&Pf, &pw, 16);
#pragma unroll
                for (int dt = 0; dt < 4; ++dt) { const bf16_t* vr = Vl + (16 * dt + ql) * 264 + 4 * q4; const u32x2 va = *(const u32x2*)(vr + 16 * cA_), vb = *(const u32x2*)(vr + 16 * cB_);
                    u32x4 vw; vw.x = va.x; vw.y = va.y; vw.z = vb.x; vw.w = vb.y; bf16x8 Vf; __builtin_memcpy(&Vf, &vw, 16);
                    o[dt] = __builtin_amdgcn_mfma_f32_16x16x32_bf16(Pf, Vf, o[dt], 0, 0, 0); } }
#pragma unroll
            for (int j = 0; j < 4; ++j) { const float li = __shfl(linv, 4 * q4 + j); bf16_t* op = zb + ((size_t)(b * SEQ + s0 + 16 * w + 4 * q4 + j)) * ZW + 2048 + h * 64 + ql;
#pragma unroll
                for (int dt = 0; dt < 4; ++dt) op[16 * dt] = (bf16_t)(cvt_pk_bf16(o[dt][j] * li, 0.f) & 0xffff); }
        }
    }
}

__device__ __forceinline__ void x_init(const Params& P) {
    const int tidx = ltid();
    const int lane = tidx & 63, gw = blockIdx.x * 8 + (tidx >> 6), nw = gridDim.x * 8;
    bf16_t* xb0 = (bf16_t*)(P.ws + OFF_XB0); float* ssq0 = (float*)(P.ws + OFF_SSQ);
    for (int row = gw; row < T_TOK; row += nw) { float ss = 0.f;
#pragma unroll
        for (int k = 0; k < 4; ++k) { const size_t o = (size_t)row * 1024 + k * 256 + lane * 4; const f32x4 v = *(const f32x4*)(P.x + o);
            u32x2 w; w.x = cvt_pk_bf16(v[0], v[1]); w.y = cvt_pk_bf16(v[2], v[3]); *(u32x2*)(xb0 + o) = w;
            *(unsigned*)(P.ws + OFF_ZB + (size_t)row * (ZW * 2) + k * 256 + lane * 4) = pack4_fp8(v[0], v[1], v[2], v[3]); ss += (v[0] * v[0] + v[1] * v[1]) + (v[2] * v[2] + v[3] * v[3]); }
#pragma unroll
        for (int o = 32; o >= 1; o >>= 1) ss += __shfl_xor(ss, o);
        if (lane < 16) ssq0[((size_t)(lane >> 2) * T_TOK + row) * 4 + (lane & 3)] = lane == 0 ? ss : 0.f; }
}
__device__ __forceinline__ void bias_table(const Params& P) {
    const int tidx = ltid();
    if (blockIdx.x == 0) for (int i = tidx; i < 1024; i += 512) { const int h = i >> 7, dist = i & 127; int bucket;
        if (dist < 16) bucket = dist; else { bucket = 16 + (int)(logf((float)dist / 16.0f) / 2.0794415416798357f * 16.0f); bucket = bucket < 31 ? bucket : 31; }
        ((float*)(P.ws + OFF_BIAS))[i] = P.rel_bias[bucket * 8 + h]; }
}
__device__ __forceinline__ void final_norm(const Params& P) {
    const int tidx = ltid();
    const float* ssq0 = (const float*)(P.ws + OFF_SSQ); const bf16_t* xb0 = (const bf16_t*)(P.ws + OFF_XB0);
    const int lane = tidx & 63, gw = blockIdx.x * 8 + (tidx >> 6), nw = gridDim.x * 8;
    f32x4 g[4];
#pragma unroll
    for (int k = 0; k < 4; ++k) g[k] = *(const f32x4*)(P.norm_final + k * 256 + lane * 4);
    for (int row = gw; row < T_TOK; row += nw) {
        float t = 0.f; if (lane < 16) t = __uint_as_float(__hip_atomic_load((unsigned*)(ssq0 + ((size_t)(lane >> 2) * T_TOK + row) * 4 + (lane & 3)), __ATOMIC_RELAXED, __HIP_MEMORY_SCOPE_AGENT));
#pragma unroll
        for (int o = 8; o >= 1; o >>= 1) t += __shfl_xor(t, o);
        const float rs = rsqrtf(__shfl(t, 0) * (1.0f / 1024.0f) + 1e-6f);
#pragma unroll
        for (int k = 0; k < 4; ++k) { const size_t o = (size_t)row * 1024 + k * 256 + lane * 4; const u32x2 w = *(const u32x2*)(xb0 + o);
            f32x4 v; v[0] = bf_lo(w.x); v[1] = bf_hi(w.x); v[2] = bf_lo(w.y); v[3] = bf_hi(w.y); *(f32x4*)(P.out + o) = v * rs * g[k]; }
    }
}


#define XB_TMO      128
#define XB_XCNT(j)  (256  + 64 * (j))
#define XB_XSUB(j)  (1280 + 64 * (j))
#define XB_XGEN(j)  (2304 + 64 * (j))
#define XB_TOP      3328
#define XB_TOPGEN   3392
#define XCD_BAR_WORDS 3456
#define XB_SPIN_CAP (1u << 20)
__device__ __forceinline__ unsigned xb_ld(unsigned* p)              { return __hip_atomic_load(p, __ATOMIC_RELAXED, __HIP_MEMORY_SCOPE_AGENT); }
__device__ __forceinline__ unsigned xb_add(unsigned* p, unsigned v) { return __hip_atomic_fetch_add(p, v, __ATOMIC_RELAXED, __HIP_MEMORY_SCOPE_AGENT); }
__device__ __forceinline__ unsigned xb_xcc_id() { return (unsigned)__builtin_amdgcn_s_getreg((3 << 11) | 20) & 0xFu; }
#define XB_SPIN(cond, bar) do { unsigned _sp = 0; while (cond) { __builtin_amdgcn_s_sleep(1); \
    if ((++_sp & 255u) == 0u) { if (xb_ld(&(bar)[XB_TMO])) break; if (_sp > XB_SPIN_CAP) { atomicAdd(&(bar)[XB_TMO], 1u); break; } } } } while (0)
struct XcdBarrier { unsigned* bar; unsigned x; volatile LAS unsigned* st; };
__device__ __forceinline__ XcdBarrier xcd_barrier_post(unsigned* bar, volatile LAS unsigned* st) {
    XcdBarrier b; b.bar = bar; b.x = xb_xcc_id(); b.st = st;
    if (threadIdx.x == 0) (void)xb_add(&bar[XB_XCNT(b.x)], 1u);
    return b;
}
__device__ __forceinline__ void xcd_barrier_complete(unsigned* bar, unsigned x, unsigned& nloc, unsigned& nx) {
    const unsigned G = gridDim.x * gridDim.y * gridDim.z;
    unsigned sum, cnt, mine, sp = 0u;
    for (;;) {
        sum = 0u; cnt = 0u; mine = 0u;
#pragma unroll
        for (unsigned j = 0; j < 16; ++j) { const unsigned c = xb_ld(&bar[XB_XCNT(j)]); sum += c; cnt += (c > 0u) ? 1u : 0u; mine = (j == x) ? c : mine; }
        if (sum == G) break;
        __builtin_amdgcn_s_sleep(1);
        if ((++sp & 255u) == 0u) { if (xb_ld(&bar[XB_TMO])) break; if (sp > XB_SPIN_CAP) { atomicAdd(&bar[XB_TMO], 1u); break; } }
    }
    nloc = mine > 0u ? mine : 1u; nx = cnt > 0u ? cnt : 1u;
}
__device__ __forceinline__ void xcd_barrier(const XcdBarrier& b) {
    asm volatile("s_waitcnt vmcnt(0)" ::: "memory");
    __syncthreads();
    if (threadIdx.x == 0) {
        unsigned* bar = b.bar;
        __builtin_amdgcn_s_waitcnt(0);
        unsigned nloc = b.st[0], nx = b.st[1];
        if (nloc == 0u) { xcd_barrier_complete(bar, b.x, nloc, nx); b.st[0] = nloc; b.st[1] = nx; }
        const unsigned old = xb_add(&bar[XB_XSUB(b.x)], 1u);
        const unsigned gen = old / nloc;
        if (old + 1u == (gen + 1u) * nloc) {
            __builtin_amdgcn_fence(__ATOMIC_RELEASE, "agent");
            asm volatile("s_waitcnt vmcnt(0)" ::: "memory");
            const unsigned og = xb_add(&bar[XB_TOP], 1u);
            const unsigned tg = og / nx;
            if (og + 1u == (tg + 1u) * nx) xb_add(&bar[XB_TOPGEN], 1u);
            else XB_SPIN(xb_ld(&bar[XB_TOPGEN]) == tg, bar);
            __builtin_amdgcn_fence(__ATOMIC_ACQUIRE, "agent");
            xb_add(&bar[XB_XGEN(b.x)], 1u);
            asm volatile("s_waitcnt vmcnt(0)" ::: "memory");
        } else {
            XB_SPIN(xb_ld(&bar[XB_XGEN(b.x)]) == gen, bar);
            __builtin_amdgcn_fence(__ATOMIC_ACQUIRE, "agent");
            asm volatile("s_waitcnt vmcnt(0)" ::: "memory");
        }
    }
    __syncthreads();
}

typedef const Params __attribute__((address_space(4)))* CParams;
#define LOADP(Pl) Params Pl; { CParams q_ = pk; asm volatile("" : "+s"(q_)); Pl = *q_; }
#define MAKE_E(E, Pl) Epi E; E.ws = Pl.ws; E.x = Pl.out; E.dskip = Pl.ssm_d + layer * 512; E.layer = layer; E.rstab = (const LAS float*)(lds + STAGE_BYTES + 16);
__global__ void __launch_bounds__(512) fwd_megakernel(Params Parg) {
#if defined(__HIP_DEVICE_COMPILE__)
    cg::grid_group grid = cg::this_grid();
    extern __shared__ __attribute__((aligned(16))) unsigned char smem[];
    LAS unsigned char* lds = (LAS unsigned char*)smem;
    CParams pk = (CParams)__builtin_amdgcn_kernarg_segment_ptr();
    volatile LAS unsigned* xst = (volatile LAS unsigned*)(lds + STAGE_BYTES);
    if (threadIdx.x == 0) { xst[0] = 0u; xst[1] = 0u; }
    __syncthreads();
    XcdBarrier xb; { LOADP(P) xb = xcd_barrier_post((unsigned*)(P.ws + OFF_BAR), xst); }
    { LOADP(P) x_init(P); bias_table(P); }
    { LOADP(P) ssm_ktable(smem, P); }
    { LOADP(P) ssm_group_tables_all(P); }
    __syncthreads();
    { LOADP(P) convert_layer(smem, P, 0, 0); }
    if (pk->ws == nullptr) grid.sync();
    xcd_barrier(xb);
    for (int layer = 0; layer < N_LAYERS; ++layer) {
        { LOADP(P) MAKE_E(E, P) gemm_phase<PH_WIN>(lds, E); }
        if (gridDim.x == 256) { if (blockIdx.x >= 128) { LOADP(P) ssm_tables(smem, P, layer, (blockIdx.x - 128) * 2, (blockIdx.x - 128) * 2 + 2, 1); } }
        else { LOADP(P) ssm_tables(smem, P, layer, blockIdx.x, 256, gridDim.x); }
        xcd_barrier(xb);
        { LOADP(P) MAKE_E(E, P) gemm_phase<PH_SSM1>(lds, E); }
        { LOADP(P) attn_phase(smem, P, layer); }
        { LOADP(P) conv_phase(P, layer); }
        xcd_barrier(xb);
        { LOADP(P) ssm_scan(P); }
        if (layer + 1 < N_LAYERS) { LOADP(P) convert_layer(smem, P, layer + 1, 16); }
        xcd_barrier(xb);
        { LOADP(P) MAKE_E(E, P) gemm_phase<PH_SSM2>(lds, E); }
        xcd_barrier(xb);
        { LOADP(P) MAKE_E(E, P) gemm_phase<PH_GLU>(lds, E); }
        xcd_barrier(xb);
        { LOADP(P) MAKE_E(E, P) gemm_phase<PH_MERGE, 0>(lds, E); }
        { LOADP(P) MAKE_E(E, P) gemm_phase<PH_MERGE, 1>(lds, E); }
        xcd_barrier(xb);
        { LOADP(P) MAKE_E(E, P) gemm_phase<PH_WOUT>(lds, E); }
        xcd_barrier(xb);
        { LOADP(P) MAKE_E(E, P) gemm_phase<PH_FFI>(lds, E); }
        xcd_barrier(xb);
        { LOADP(P) MAKE_E(E, P) gemm_phase<PH_FFO>(lds, E); }
        xcd_barrier(xb);
        { LOADP(P) MAKE_E(E, P) gemm_phase<PH_PLE, 0>(lds, E); }
        { LOADP(P) MAKE_E(E, P) gemm_phase<PH_PLE, 1>(lds, E); }
        xcd_barrier(xb);
    }
    { LOADP(P) final_norm(P); }
#endif
}

extern "C" void kernel_launch(void* const* d_in, const int* in_sizes, int n_in, void* d_out, int out_size, void* d_ws, size_t ws_size, hipStream_t stream) {
    constexpr size_t kDynLds = STAGE_BYTES + 16 + 12 * 1024;
    static int grid_blocks = 0;
    if (!grid_blocks) {
        int dev = 0, cus = 0, per_cu = 0;
        hipGetDevice(&dev);
        hipDeviceGetAttribute(&cus, hipDeviceAttributeMultiprocessorCount, dev);
        hipFuncSetAttribute((const void*)fwd_megakernel, hipFuncAttributeMaxDynamicSharedMemorySize, (int)kDynLds);
        hipOccupancyMaxActiveBlocksPerMultiprocessor(&per_cu, fwd_megakernel, 512, kDynLds);
        if (per_cu < 1) per_cu = 1;
        grid_blocks = cus * 1;
    }
    Params P{};
    const float** f = (const float**)&P;
    for (int i = 0; i < 25; ++i) f[i] = (const float*)d_in[i];
    P.out = (float*)d_out; P.ws = (unsigned char*)d_ws;
    (void)hipMemsetAsync((char*)d_ws + OFF_BAR, 0, XCD_BAR_WORDS * sizeof(unsigned), stream);
    void* args[] = {&P};
    hipError_t e = hipLaunchCooperativeKernel((void*)fwd_megakernel, dim3(grid_blocks), dim3(512), args, kDynLds, stream);
    if (e != hipSuccess) fprintf(stderr, "cooperative launch failed: %s (grid %d)\n", hipGetErrorString(e), grid_blocks);
}
```
